# Optimizing an MI355X kernel written in HIP

```python
import jax, jax.numpy as jnp
from jax import lax
import numpy as np

D_MODEL = 1024
BATCH = 4
SEQ = 8192
DEPTH = 1

PLE_DIM = 256
EPS = 1e-6
ROPE_THETA = 10000.0
D_FF = 2816

NSA_HEADS = 8
NSA_KV_HEADS = 2
HEAD_DIM = 64
HPG = NSA_HEADS // NSA_KV_HEADS
NSA_WIDTH = NSA_HEADS * HEAD_DIM
KV_WIDTH = NSA_KV_HEADS * HEAD_DIM
CMP_LEN = 32
CMP_STRIDE = 16
CMP_HIDDEN = 256
SEL_LEN = 64
N_SEL = 16
N_LOCAL = 2
WINDOW = 512
Q_BLOCK = 128
NEG = -1e30
FORCED_SCORE = 1e4
INVALID_SCORE = -1e4

CONV_WIDTH = 512
CONV_K = 3

SPLIT_SIZES = (NSA_WIDTH, KV_WIDTH, KV_WIDTH, KV_WIDTH, KV_WIDTH, KV_WIDTH, KV_WIDTH,
               3 * NSA_HEADS, CONV_WIDTH, CONV_WIDTH, CONV_WIDTH, D_MODEL, D_MODEL)
IN_COLS = 4888

kernel_name = "hybrid_nsa_shortconv_macaron_block"


def rms_norm(x, g):
    xf = x.astype(jnp.float32)
    y = xf * lax.rsqrt(jnp.mean(xf * xf, axis=-1, keepdims=True) + EPS)
    return (y * g.astype(jnp.float32)).astype(x.dtype)


def swiglu(x, w_gate, w_up, w_down):
    return (jax.nn.silu(x @ w_gate) * (x @ w_up)) @ w_down


def rope(x, positions):
    half = HEAD_DIM // 2
    inv_freq = ROPE_THETA ** (-jnp.arange(half, dtype=jnp.float32) / half)
    ang = positions.astype(jnp.float32)[..., None] * inv_freq
    cos = jnp.cos(ang)[:, :, None, :]
    sin = jnp.sin(ang)[:, :, None, :]
    x1 = x[..., :half].astype(jnp.float32)
    x2 = x[..., half:].astype(jnp.float32)
    out = jnp.concatenate([x1 * cos - x2 * sin, x2 * cos + x1 * sin], axis=-1)
    return out.astype(x.dtype)


def compress(kv, pos_emb, w1, b1, w2):
    B, S, G, dh = kv.shape
    nc = (S - CMP_LEN) // CMP_STRIDE + 1
    idx = jnp.arange(nc)[:, None] * CMP_STRIDE + jnp.arange(CMP_LEN)[None, :]
    blocks = kv[:, idx] + pos_emb[None, None, :, None, :]
    flat = blocks.transpose(0, 1, 3, 2, 4).reshape(B, nc, G, CMP_LEN * dh)
    return jax.nn.gelu(flat @ w1 + b1) @ w2


def nsa_attention(q, kc, vc, ks, vs, kw, vw, gates):
    B, S = q.shape[0], q.shape[1]
    G = NSA_KV_HEADS
    nc = kc.shape[1]
    ns = S // SEL_LEN
    n_sel = min(N_SEL, ns)
    nqb = S // Q_BLOCK
    scale = HEAD_DIM ** -0.5
    f32 = jnp.float32

    ks_blk = ks.reshape(B, ns, SEL_LEN, G, HEAD_DIM).transpose(0, 3, 1, 2, 4)
    vs_blk = vs.reshape(B, ns, SEL_LEN, G, HEAD_DIM).transpose(0, 3, 1, 2, 4)
    pad = ((0, 0), (WINDOW, 0), (0, 0), (0, 0))
    kw_pad = jnp.pad(kw, pad)
    vw_pad = jnp.pad(vw, pad)

    c_start = jnp.arange(nc) * CMP_STRIDE
    c_last = c_start + CMP_LEN - 1
    s_start = jnp.arange(ns) * SEL_LEN
    overlap = jnp.clip(jnp.minimum(c_start[:, None] + CMP_LEN, s_start[None, :] + SEL_LEN)
                       - jnp.maximum(c_start[:, None], s_start[None, :]), 0, None).astype(f32) / CMP_LEN
    s_idx = jnp.arange(ns)
    sel_off = jnp.arange(SEL_LEN)
    win_off = jnp.arange(Q_BLOCK + WINDOW)

    def block(args):
        qb, gb, qs = args
        tq = qs + jnp.arange(Q_BLOCK)

        s_c = jnp.einsum('bqghd,bcgd->bghqc', qb, kc, preferred_element_type=f32) * scale
        c_mask = c_last[None, :] <= tq[:, None]
        p_c = jax.nn.softmax(jnp.where(c_mask, s_c, NEG), axis=-1)
        p_c = p_c * jnp.any(c_mask, axis=-1)[:, None].astype(f32)
        o_c = jnp.einsum('bghqc,bcgd->bqghd', p_c.astype(vc.dtype), vc)

        imp = jnp.einsum('bghqc,cs->bgqs', p_c, overlap)
        blk_q = tq // SEL_LEN
        valid = s_idx[None, :] <= blk_q[:, None]
        forced = (s_idx[None, :] == 0) | (valid & (s_idx[None, :] > blk_q[:, None] - N_LOCAL))
        score = jnp.where(forced, FORCED_SCORE, jnp.where(valid, imp, INVALID_SCORE))
        _, sel = lax.top_k(score, n_sel)

        gather = jax.vmap(jax.vmap(lambda kb, ix: kb[ix]))
        gk = gather(ks_blk, sel)
        gv = gather(vs_blk, sel)
        tok = sel[..., None] * SEL_LEN + sel_off
        t_mask = (tok <= tq[None, None, :, None, None])[:, :, None]
        s_s = jnp.einsum('bqghd,bgqnld->bghqnl', qb, gk, preferred_element_type=f32) * scale
        s_s = jnp.where(t_mask, s_s, NEG)
        sh = s_s.shape
        p_s = jax.nn.softmax(s_s.reshape(sh[:4] + (sh[4] * sh[5],)), axis=-1).reshape(sh)
        o_s = jnp.einsum('bghqnl,bgqnld->bqghd', p_s.astype(gv.dtype), gv)

        kwb = lax.dynamic_slice_in_dim(kw_pad, qs, Q_BLOCK + WINDOW, axis=1)
        vwb = lax.dynamic_slice_in_dim(vw_pad, qs, Q_BLOCK + WINDOW, axis=1)
        kpos = qs - WINDOW + win_off
        w_mask = ((kpos[None, :] <= tq[:, None]) & (kpos[None, :] > tq[:, None] - WINDOW)
                  & (kpos[None, :] >= 0))
        s_w = jnp.einsum('bqghd,bkgd->bghqk', qb, kwb, preferred_element_type=f32) * scale
        p_w = jax.nn.softmax(jnp.where(w_mask, s_w, NEG), axis=-1)
        o_w = jnp.einsum('bghqk,bkgd->bqghd', p_w.astype(vwb.dtype), vwb)

        return gb[..., 0:1] * o_c + gb[..., 1:2] * o_s + gb[..., 2:3] * o_w

    def to_blocks(t):
        return jnp.moveaxis(t.reshape((B, nqb, Q_BLOCK) + t.shape[2:]), 1, 0)

    out = lax.map(block, (to_blocks(q), to_blocks(gates), jnp.arange(nqb) * Q_BLOCK))
    return jnp.moveaxis(out, 0, 1).reshape(B, S, NSA_WIDTH)


def short_conv(xb, xc, xin, w_conv, b_conv):
    u = xc * xin
    y = lax.conv_general_dilated(u, w_conv[:, None, :].astype(u.dtype), window_strides=(1,),
                                 padding=[(CONV_K - 1, 0)],
                                 dimension_numbers=('NWC', 'WIO', 'NWC'),
                                 feature_group_count=CONV_WIDTH)
    return xb * (y + b_conv)


def token_mixing(u, positions, w_in, cmp_k_pos, cmp_k_w1, cmp_k_b1, cmp_k_w2,
                 cmp_v_pos, cmp_v_w1, cmp_v_b1, cmp_v_w2, conv_w, conv_b,
                 w_proj_nsa, w_proj_conv, w_out):
    B, S, _ = u.shape
    G = NSA_KV_HEADS
    points = []
    acc = 0
    for sz in SPLIT_SIZES[:-1]:
        acc += sz
        points.append(acc)
    z = u @ w_in
    (q, kc_raw, vc_raw, ks, vs, kw, vw, g_nsa, cb, cc, cx, g_a, g_b) = jnp.split(z, points, axis=-1)

    q = rope(q.reshape(B, S, NSA_HEADS, HEAD_DIM), positions).reshape(B, S, G, HPG, HEAD_DIM)
    kc = compress(rope(kc_raw.reshape(B, S, G, HEAD_DIM), positions), cmp_k_pos, cmp_k_w1, cmp_k_b1, cmp_k_w2)
    vc = compress(vc_raw.reshape(B, S, G, HEAD_DIM), cmp_v_pos, cmp_v_w1, cmp_v_b1, cmp_v_w2)
    ks = rope(ks.reshape(B, S, G, HEAD_DIM), positions)
    vs = vs.reshape(B, S, G, HEAD_DIM)
    kw = rope(kw.reshape(B, S, G, HEAD_DIM), positions)
    vw = vw.reshape(B, S, G, HEAD_DIM)
    gates = jax.nn.sigmoid(g_nsa.reshape(B, S, G, HPG, 3))

    o_nsa = nsa_attention(q, kc, vc, ks, vs, kw, vw, gates)
    o_conv = short_conv(cb, cc, cx, conv_w, conv_b)
    merged = (jax.nn.sigmoid(g_a) * (o_nsa @ w_proj_nsa)
              + jax.nn.sigmoid(g_b) * (o_conv @ w_proj_conv))
    return merged @ w_out


def setup_inputs(seed: int = 0) -> dict:
    key = jax.random.key(seed)
    ks = iter(jax.random.split(key, 40))
    f32 = jnp.float32

    def nrm(shape, scale):
        return jax.random.normal(next(ks), shape, f32) * scale

    def gain(shape):
        return 1.0 + 0.1 * jax.random.normal(next(ks), shape, f32)

    L = DEPTH
    x = jax.random.normal(next(ks), (BATCH, SEQ, D_MODEL), f32)
    p = jax.random.normal(next(ks), (DEPTH, BATCH, SEQ, PLE_DIM), f32)
    offsets = jax.random.randint(next(ks), (BATCH, 1), 0, 4096, dtype=jnp.int32)
    positions = offsets + jnp.arange(SEQ, dtype=jnp.int32)[None, :]
    return {
        "x": x,
        "p": p,
        "positions": positions,
        "ffn1_norm": gain((L, D_MODEL)),
        "ffn1_w_gate": nrm((L, D_MODEL, D_FF), D_MODEL ** -0.5),
        "ffn1_w_up": nrm((L, D_MODEL, D_FF), D_MODEL ** -0.5),
        "ffn1_w_down": nrm((L, D_FF, D_MODEL), D_FF ** -0.5),
        "mix_norm": gain((L, D_MODEL)),
        "w_in": nrm((L, D_MODEL, IN_COLS), D_MODEL ** -0.5),
        "cmp_k_pos": nrm((L, CMP_LEN, HEAD_DIM), 0.1),
        "cmp_k_w1": nrm((L, CMP_LEN * HEAD_DIM, CMP_HIDDEN), (CMP_LEN * HEAD_DIM) ** -0.5),
        "cmp_k_b1": nrm((L, CMP_HIDDEN), 0.01),
        "cmp_k_w2": nrm((L, CMP_HIDDEN, HEAD_DIM), CMP_HIDDEN ** -0.5),
        "cmp_v_pos": nrm((L, CMP_LEN, HEAD_DIM), 0.1),
        "cmp_v_w1": nrm((L, CMP_LEN * HEAD_DIM, CMP_HIDDEN), (CMP_LEN * HEAD_DIM) ** -0.5),
        "cmp_v_b1": nrm((L, CMP_HIDDEN), 0.01),
        "cmp_v_w2": nrm((L, CMP_HIDDEN, HEAD_DIM), CMP_HIDDEN ** -0.5),
        "conv_w": nrm((L, CONV_K, CONV_WIDTH), 0.5),
        "conv_b": nrm((L, CONV_WIDTH), 0.01),
        "w_proj_nsa": nrm((L, NSA_WIDTH, D_MODEL), NSA_WIDTH ** -0.5),
        "w_proj_conv": nrm((L, CONV_WIDTH, D_MODEL), CONV_WIDTH ** -0.5),
        "w_out": nrm((L, D_MODEL, D_MODEL), D_MODEL ** -0.5),
        "ffn2_norm": gain((L, D_MODEL)),
        "ffn2_w_gate": nrm((L, D_MODEL, D_FF), D_MODEL ** -0.5),
        "ffn2_w_up": nrm((L, D_MODEL, D_FF), D_MODEL ** -0.5),
        "ffn2_w_down": nrm((L, D_FF, D_MODEL), D_FF ** -0.5),
        "ple_norm": gain((L, D_MODEL)),
        "ple_w_gate": nrm((L, D_MODEL, D_MODEL), D_MODEL ** -0.5),
        "ple_w_proj": nrm((L, PLE_DIM, D_MODEL), PLE_DIM ** -0.5),
        "final_norm": gain((D_MODEL,)),
    }


def reference(x, p, positions, ffn1_norm, ffn1_w_gate, ffn1_w_up, ffn1_w_down,
              mix_norm, w_in, cmp_k_pos, cmp_k_w1, cmp_k_b1, cmp_k_w2,
              cmp_v_pos, cmp_v_w1, cmp_v_b1, cmp_v_w2, conv_w, conv_b,
              w_proj_nsa, w_proj_conv, w_out, ffn2_norm, ffn2_w_gate, ffn2_w_up, ffn2_w_down,
              ple_norm, ple_w_gate, ple_w_proj, final_norm):
    h = x
    for i in range(DEPTH):
        h = h + 0.5 * swiglu(rms_norm(h, ffn1_norm[i]), ffn1_w_gate[i], ffn1_w_up[i], ffn1_w_down[i])
        h = h + token_mixing(rms_norm(h, mix_norm[i]), positions, w_in[i],
                             cmp_k_pos[i], cmp_k_w1[i], cmp_k_b1[i], cmp_k_w2[i],
                             cmp_v_pos[i], cmp_v_w1[i], cmp_v_b1[i], cmp_v_w2[i],
                             conv_w[i], conv_b[i], w_proj_nsa[i], w_proj_conv[i], w_out[i])
        h = h + 0.5 * swiglu(rms_norm(h, ffn2_norm[i]), ffn2_w_gate[i], ffn2_w_up[i], ffn2_w_down[i])
        h = h + jax.nn.sigmoid(rms_norm(h, ple_norm[i]) @ ple_w_gate[i]) * (p[i] @ ple_w_proj[i])
    return rms_norm(h, final_norm)
```

```cpp
#include <hip/hip_runtime.h>
#include <hip/hip_cooperative_groups.h>
#include <cstdio>
#include <cstdint>
#include <cmath>
namespace cg = cooperative_groups;
#ifndef SPLIT_LAUNCH
#define SPLIT_LAUNCH 0
#endif
#ifndef EPI_DRAIN
#define EPI_DRAIN 0
#endif
#ifndef DBG_GATE
#define DBG_GATE 0
#endif
#ifndef DBG_STRAT
#define DBG_STRAT 1
#endif
#ifndef ATTN_REPS
#define ATTN_REPS 1
#endif
#ifndef GP_ALIGN
#define GP_ALIGN true
#endif
#ifndef GP_SP2
#define GP_SP2 true
#endif
namespace pg8 {
#define PG8_LAS __attribute__((address_space(3)))
typedef unsigned short bf16_t;
typedef short bf16x8 __attribute__((ext_vector_type(8)));
typedef float f32x4 __attribute__((ext_vector_type(4)));
typedef unsigned u32x4 __attribute__((ext_vector_type(4)));
constexpr int BM = 256, BK = 64, HALF = 128, HTB = HALF * BK * 2  , STAGE_BYTES = 8 * HTB, NXCD = 8, WGM = 8;

__host__ __device__ __forceinline__ int lds_byte(int r, int c) { const int st = (r >> 4) * 2 + (c >> 5), rr = r & 15, cc = c & 31, ob = rr * 64 + cc * 2; return st * 1024 + (ob ^ (((ob >> 9) & 1) << 5)); }
__host__ __device__ __forceinline__ void stage_rc(int b, int& R, int& C) { const int st = b / 1024, sb = b % 1024, swz = sb ^ (((sb >> 9) & 1) << 5); R = (st >> 1) * 16 + swz / 64; C = (st & 1) * 32 + (swz % 64) / 2; }
__host__ __device__ __forceinline__ int perm32(int rho) { const int n = rho >> 4, i = rho & 15; return 8 * (i >> 2) + 4 * n + (i & 3); }

struct Unit { int pm, pn; };
struct Gemm { const bf16_t* A; const bf16_t* Bt; int M, N, K, lda; };

struct StaticOrder {
    int nM, nN, nwg, G, c;
    __host__ __device__ void init(int M, int N, int G_, int c_) { nM = M / BM; nN = N / BM; nwg = nM * nN; G = G_; c = c_; }
    __host__ __device__ bool next(int i, Unit& u) const {
        const long L = (long)i * G + c; if (L >= nwg) return false;
        int wgid = (int)L; { const int q = nwg / NXCD, r = nwg % NXCD, xcd = wgid % NXCD, off = wgid / NXCD; wgid = (xcd < r ? xcd * (q + 1) : r * (q + 1) + (xcd - r) * q) + off; }
        const int nig = WGM * nN, gid = wgid / nig, fm = gid * WGM, gsz = (nM - fm) < WGM ? (nM - fm) : WGM;
        u.pm = fm + ((wgid % nig) % gsz); u.pn = (wgid % nig) / gsz; return true;
    }
    __device__ __forceinline__ void a_ready(const Unit&) const {}
    __device__ __forceinline__ void done(const Unit&) const {}
};

template <class Epi, class Sched, bool ALIGN_EPI = false, bool SP2 = false>
__device__ __forceinline__ void gemm_phase(PG8_LAS unsigned char* lds, const Gemm g, const Sched& S, const Epi& E) {
    int tid_ = threadIdx.x; asm volatile("" : "+v"(tid_));
    const int tid = tid_, wid = __builtin_amdgcn_readfirstlane(tid >> 6), lane = tid & 63, wr = wid >> 2, wc = wid & 3, fr = lane & 15, fq = lane >> 4;
    const int K = g.K, nt = K / BK;
    unsigned voffA[2], voffB[2];
#pragma unroll
    for (int i = 0; i < 2; ++i) { int R, C; stage_rc(tid * 16 + i * 8192, R, C); const int Rb = Epi::PERM ? ((R & ~31) + perm32(R & 31)) : R;
        voffA[i] = (unsigned)(R * g.lda + C) * 2u; voffB[i] = (unsigned)(Rb * K + C) * 2u; }
    const size_t kstep = (size_t)(BK * 2);
    const size_t hstepA = (size_t)HALF * g.lda * 2, hstepB = (size_t)HALF * K * 2;
    const size_t tstepA = 2 * hstepA, tstepB = 2 * hstepB;
    const unsigned ldsw = (unsigned)wid * 1024u;
    const int aoff = lds_byte(wr * 64 + fr, fq * 8), boff = lds_byte(wc * 32 + fr, fq * 8);
#define PG8_SA(b, h) (((b) * 2 + (h)) * HTB)
#define PG8_SB(b, h) ((4 + (b) * 2 + (h)) * HTB)
#define PG8_STAGE(bufoff, gbase, voff) do { _Pragma("unroll") for (int _i = 0; _i < 2; ++_i) \
        __builtin_amdgcn_global_load_lds((const unsigned*)((const char*)(gbase) + (voff)[_i]), (PG8_LAS unsigned*)(lds + (bufoff) + ldsw + _i * 8192), 16, 0, 0); } while (0)
#define PG8_LDA(dst, b, h) do { _Pragma("unroll") for (int m = 0; m < 4; ++m) _Pragma("unroll") for (int k = 0; k < 2; ++k) dst[m][k] = *(const PG8_LAS bf16x8*)(lds + PG8_SA(b, h) + aoff + m * 2048 + k * 1024); } while (0)
#define PG8_LDB(dst, b, h) do { _Pragma("unroll") for (int n = 0; n < 2; ++n) _Pragma("unroll") for (int k = 0; k < 2; ++k) dst[n][k] = *(const PG8_LAS bf16x8*)(lds + PG8_SB(b, h) + boff + n * 2048 + k * 1024); } while (0)
#define PG8_MMA(ai, bj, At, Bt) do { __builtin_amdgcn_s_setprio(1); _Pragma("unroll") for (int m = 0; m < 4; ++m) _Pragma("unroll") for (int n = 0; n < 2; ++n) _Pragma("unroll") for (int k = 0; k < 2; ++k) \
        acc[ai][bj][m][n] = __builtin_amdgcn_mfma_f32_16x16x32_bf16(Bt[n][k], At[m][k], acc[ai][bj][m][n], 0, 0, 0); __builtin_amdgcn_s_setprio(0); } while (0)
#define PG8_WAIT_V(n) asm volatile("s_waitcnt vmcnt(" #n ")" ::: "memory")
#define PG8_WAIT_L(n) asm volatile("s_waitcnt lgkmcnt(" #n ")" ::: "memory")
#define PG8_BAR __builtin_amdgcn_s_barrier()
#define PG8_SCHED __builtin_amdgcn_sched_barrier(0)
    Unit cur, nxt; int ui = 0;
    if (!S.next(0, cur)) return;
    f32x4 acc[2][2][4][2];
#pragma unroll
    for (int a = 0; a < 2; ++a)
#pragma unroll
        for (int b = 0; b < 2; ++b)
#pragma unroll
            for (int m = 0; m < 4; ++m)
#pragma unroll
                for (int n = 0; n < 2; ++n) acc[a][b][m][n] = (f32x4){0.f, 0.f, 0.f, 0.f};
    bf16x8 At[4][2], B0[2][2], B1[2][2];
    const char* cA = (const char*)g.A + (size_t)cur.pm * tstepA; const char* cB = (const char*)g.Bt + (size_t)cur.pn * tstepB;
    S.a_ready(cur);
    if constexpr (SP2) {
        PG8_STAGE(PG8_SB(0, 0), cB, voffB); PG8_STAGE(PG8_SB(0, 1), cB + hstepB, voffB); PG8_STAGE(PG8_SA(0, 0), cA, voffA); PG8_STAGE(PG8_SA(0, 1), cA + hstepA, voffA);
        if (wr == 1) PG8_BAR;
        PG8_WAIT_V(2); PG8_BAR;
        PG8_STAGE(PG8_SB(1, 0), cB + kstep, voffB); PG8_STAGE(PG8_SA(1, 0), cA + kstep, voffA); PG8_STAGE(PG8_SB(1, 1), cB + hstepB + kstep, voffB);
        PG8_WAIT_V(6); PG8_BAR;
    } else {
        PG8_STAGE(PG8_SB(0, 0), cB, voffB); PG8_STAGE(PG8_SA(0, 0), cA, voffA); PG8_STAGE(PG8_SB(0, 1), cB + hstepB, voffB); PG8_STAGE(PG8_SA(0, 1), cA + hstepA, voffA);
        if (wr == 1) PG8_BAR;
        PG8_WAIT_V(4); PG8_BAR;
        PG8_STAGE(PG8_SB(1, 0), cB + kstep, voffB); PG8_STAGE(PG8_SA(1, 0), cA + kstep, voffA); PG8_STAGE(PG8_SB(1, 1), cB + hstepB + kstep, voffB);
        PG8_WAIT_V(6); PG8_BAR;
    }
    for (;;) {
        const bool has_next = S.next(ui + 1, nxt);
        const char* nA = has_next ? (const char*)g.A + (size_t)nxt.pm * tstepA : cA; const char* nB = has_next ? (const char*)g.Bt + (size_t)nxt.pn * tstepB : cB;
        for (int t = 0; t < nt; t += 2) {
            const bool last = (t == nt - 2);
            const char* a1 = cA + (size_t)(t + 1) * kstep;
            const char* a2 = last ? nA : cA + (size_t)(t + 2) * kstep; const char* b2 = last ? nB : cB + (size_t)(t + 2) * kstep;
            const char* a3 = a2 + kstep; const char* b3 = b2 + kstep;
            if (last && has_next) S.a_ready(nxt);
            if constexpr (SP2) {
            PG8_LDB(B0, 0, 0); PG8_LDB(B1, 0, 1); PG8_SCHED; PG8_LDA(At, 0, 0); PG8_STAGE(PG8_SA(1, 1), a1 + hstepA, voffA);
            PG8_WAIT_V(8); PG8_WAIT_L(0); PG8_BAR; PG8_MMA(0, 0, At, B0); PG8_MMA(0, 1, At, B1); PG8_BAR; PG8_SCHED;
            PG8_LDA(At, 0, 1); PG8_STAGE(PG8_SB(0, 0), b2, voffB); PG8_STAGE(PG8_SB(0, 1), b2 + hstepB, voffB); PG8_STAGE(PG8_SA(0, 0), a2, voffA);
            PG8_WAIT_V(8); PG8_WAIT_L(0); PG8_BAR; PG8_MMA(1, 0, At, B0); PG8_MMA(1, 1, At, B1); PG8_BAR; PG8_SCHED;
            PG8_LDB(B0, 1, 0); PG8_LDB(B1, 1, 1); PG8_SCHED; PG8_LDA(At, 1, 0); PG8_STAGE(PG8_SA(0, 1), a2 + hstepA, voffA);
            PG8_WAIT_V(8); PG8_WAIT_L(0); PG8_BAR; PG8_MMA(0, 0, At, B0); PG8_MMA(0, 1, At, B1); PG8_BAR; PG8_SCHED;
            PG8_LDA(At, 1, 1); PG8_STAGE(PG8_SB(1, 0), b3, voffB); PG8_STAGE(PG8_SB(1, 1), b3 + hstepB, voffB); PG8_STAGE(PG8_SA(1, 0), a3, voffA);
            PG8_WAIT_V(8); PG8_WAIT_L(0); PG8_BAR; PG8_MMA(1, 0, At, B0); PG8_MMA(1, 1, At, B1); PG8_BAR; PG8_SCHED;
            } else {
            PG8_LDB(B0, 0, 0); PG8_SCHED; PG8_LDA(At, 0, 0); PG8_STAGE(PG8_SA(1, 1), a1 + hstepA, voffA);
            PG8_WAIT_L(8); PG8_BAR; PG8_WAIT_L(0); PG8_MMA(0, 0, At, B0); PG8_BAR; PG8_SCHED;
            PG8_LDB(B1, 0, 1); PG8_STAGE(PG8_SB(0, 0), b2, voffB);
            PG8_BAR; PG8_WAIT_L(0); PG8_MMA(0, 1, At, B1); PG8_BAR;
            PG8_LDA(At, 0, 1); PG8_STAGE(PG8_SA(0, 0), a2, voffA);
            PG8_BAR; PG8_WAIT_L(0); PG8_MMA(1, 0, At, B0); PG8_BAR; PG8_SCHED;
            PG8_STAGE(PG8_SB(0, 1), b2 + hstepB, voffB);
            PG8_WAIT_V(6); PG8_BAR; PG8_MMA(1, 1, At, B1); PG8_BAR;
            PG8_LDB(B0, 1, 0); PG8_SCHED; PG8_LDA(At, 1, 0); PG8_STAGE(PG8_SA(0, 1), a2 + hstepA, voffA);
            PG8_WAIT_L(8); PG8_BAR; PG8_WAIT_L(0); PG8_MMA(0, 0, At, B0); PG8_BAR; PG8_SCHED;
            PG8_LDB(B1, 1, 1); PG8_STAGE(PG8_SB(1, 0), b3, voffB);
            PG8_BAR; PG8_WAIT_L(0); PG8_MMA(0, 1, At, B1); PG8_BAR;
            PG8_LDA(At, 1, 1); PG8_STAGE(PG8_SA(1, 0), a3, voffA);
            PG8_BAR; PG8_WAIT_L(0); PG8_MMA(1, 0, At, B0); PG8_BAR; PG8_SCHED;
            PG8_STAGE(PG8_SB(1, 1), b3 + hstepB, voffB);
            PG8_WAIT_V(6); PG8_BAR; PG8_MMA(1, 1, At, B1); PG8_BAR;
            }
        }
        if constexpr (ALIGN_EPI) { if (wr == 0) PG8_BAR; }
        if constexpr (!Epi::AFTER_DRAIN) { E(acc, cur, wr, wc, fr, fq); S.done(cur); }
        if (!has_next) break;
#pragma unroll
        for (int a = 0; a < 2; ++a)
#pragma unroll
            for (int b = 0; b < 2; ++b)
#pragma unroll
                for (int m = 0; m < 4; ++m)
#pragma unroll
                    for (int n = 0; n < 2; ++n) acc[a][b][m][n] = (f32x4){0.f, 0.f, 0.f, 0.f};
        cur = nxt; cA = nA; cB = nB; ++ui;
        if constexpr (ALIGN_EPI) { if (wr == 1) PG8_BAR; }
    }
    PG8_WAIT_V(0);
    if constexpr (!ALIGN_EPI) { if (wr == 0) PG8_BAR; }
    PG8_BAR;
    if constexpr (Epi::AFTER_DRAIN) { E.fused(acc, cur, wr, wc, fr, fq, lds, wid, lane); S.done(cur); }
#undef PG8_SA
#undef PG8_SB
#undef PG8_STAGE
#undef PG8_LDA
#undef PG8_LDB
#undef PG8_MMA
#undef PG8_WAIT_V
#undef PG8_WAIT_L
#undef PG8_BAR
#undef PG8_SCHED
}
}

using pg8::bf16_t; using pg8::bf16x8; using pg8::f32x4; using pg8::u32x4;
typedef unsigned u32x2 __attribute__((ext_vector_type(2)));
#define LAS __attribute__((address_space(3)))

constexpr int NB = 4, SEQ = 8192, T = NB * SEQ, DM = 1024, FF = 2816;
constexpr float LOG2E = 1.4426950408889634f;
constexpr float QSCALE = 0.125f * LOG2E;
constexpr float EPSN = 1e-6f;
constexpr int WIN_COLS = 4888;
constexpr int NWAVES = 8;
constexpr int LDS_BYTES = 147456;

constexpr size_t MiB = 1u << 20;
constexpr size_t WS_F1UP = 1 * MiB, WS_F1DN = 12 * MiB, WS_F2UP = 18 * MiB, WS_F2DN = 29 * MiB, WS_WIN = 35 * MiB, WS_WGA = 41 * MiB, WS_WGB = 43 * MiB, WS_WVT = 45 * MiB;
constexpr size_t WS_CK1 = 46 * MiB, WS_CV1 = 47 * MiB, WS_CK2 = 48 * MiB, WS_CV2 = 48 * MiB + 256 * 1024, WS_PA = 49 * MiB, WS_PB = 50 * MiB;
constexpr size_t WS_WO = 51 * MiB, WS_PG = 53 * MiB, WS_PP = 55 * MiB, WS_BIASK = 512 * 1024, WS_BIASV = 512 * 1024 + 4096, WS_ROPE = 57 * MiB;
constexpr size_t WS_U = 72 * MiB;
constexpr size_t WS_H = 136 * MiB;
constexpr size_t WS_BIG = 264 * MiB;
constexpr size_t WS_Q = WS_BIG, WS_CB = WS_BIG + 32 * MiB, WS_KCR = WS_BIG + 128 * MiB, WS_VCR = WS_BIG + 136 * MiB, WS_KS = WS_BIG + 144 * MiB, WS_KW = WS_BIG + 152 * MiB, WS_VT = WS_BIG + 160 * MiB;
constexpr size_t WS_TMP = WS_BIG, WS_PBF = 56 * MiB;
constexpr size_t WS_SUMSQ = 65536;
constexpr size_t WS_SGA = WS_BIG, WS_SGB = WS_BIG + 64 * MiB;
constexpr size_t WS_TAIL = 440 * MiB;
constexpr size_t WS_GATES = WS_TAIL, WS_HCK = WS_TAIL + 3 * MiB, WS_HCV = WS_TAIL + 5 * MiB, WS_KCOMP = WS_TAIL + 7 * MiB, WS_VCOMPT = WS_TAIL + 7 * MiB + 512 * 1024;
constexpr size_t WS_ONSA = WS_TAIL + 8 * MiB, WS_OCONV = WS_TAIL + 40 * MiB, WS_END = 512 * MiB;

__device__ __forceinline__ unsigned cvt_pk_bf16(float lo, float hi) { unsigned r; asm volatile("s_nop 1\n\tv_cvt_pk_bf16_f32 %0, %1, %2" : "=v"(r) : "v"(lo), "v"(hi)); return r; }
__device__ __forceinline__ unsigned cvt_pk_bf16_t(float lo, float hi) { unsigned r; asm volatile("s_nop 1\n\tv_cvt_pk_bf16_f32 %0, %1, %2\n\ts_nop 1" : "=v"(r) : "v"(lo), "v"(hi)); return r; }
__device__ __forceinline__ u32x2 pack4_t(f32x4 a) { u32x2 w; w.x = cvt_pk_bf16_t(a[0], a[1]); w.y = cvt_pk_bf16_t(a[2], a[3]); return w; }
__device__ __forceinline__ u32x4 pack8(f32x4 a, f32x4 b) { u32x4 w; w.x = cvt_pk_bf16(a[0], a[1]); w.y = cvt_pk_bf16(a[2], a[3]); w.z = cvt_pk_bf16(b[0], b[1]); w.w = cvt_pk_bf16(b[2], b[3]); return w; }
__device__ __forceinline__ u32x2 pack4(f32x4 a) { u32x2 w; w.x = cvt_pk_bf16(a[0], a[1]); w.y = cvt_pk_bf16(a[2], a[3]); return w; }
__device__ __forceinline__ float bf_lo(unsigned w) { return __uint_as_float(w << 16); }
__device__ __forceinline__ float bf_hi(unsigned w) { return __uint_as_float(w & 0xffff0000u); }
__device__ __forceinline__ void unpack8(u32x4 w, f32x4& a, f32x4& b) { a[0] = bf_lo(w.x); a[1] = bf_hi(w.x); a[2] = bf_lo(w.y); a[3] = bf_hi(w.y); b[0] = bf_lo(w.z); b[1] = bf_hi(w.z); b[2] = bf_lo(w.w); b[3] = bf_hi(w.w); }
__device__ __forceinline__ float fsigmoid(float x) { return __builtin_amdgcn_rcpf(1.0f + __builtin_amdgcn_exp2f(-x * LOG2E)); }
__device__ __forceinline__ f32x4 sig4(f32x4 v) { f32x4 r; r[0] = fsigmoid(v[0]); r[1] = fsigmoid(v[1]); r[2] = fsigmoid(v[2]); r[3] = fsigmoid(v[3]); return r; }
__device__ __forceinline__ float gelu_tanh(float x) { const float z = 1.5957691216057308f * (x + 0.044715f * x * x * x); return x * fsigmoid(z); }

enum { K_SWIGLU = 0, K_RESID, K_WIN, K_VT, K_GELU, K_KC, K_VCT, K_PROJA, K_PROJB, K_ST32, K_SIG, K_PLE };
struct Job { const bf16_t* A; const bf16_t* Bt; int M, N, K, lda, kind, rot; void* p0; void* p1; void* p2; float scale; const float* rowss; float* ssout; };
struct WinPtrs { unsigned char* ws; bf16_t* sg; };

struct EpiSwitch {
    static constexpr bool PERM = true, AFTER_DRAIN = false;
    Job J; WinPtrs W;
    template <class F> __device__ __forceinline__ void loop(const f32x4 (&acc)[2][2][4][2], const pg8::Unit& u, int wr, int wc, int fr, int fq, const F& f) const {
        const int row0 = u.pm * 256 + wr * 64 + fr, col0 = u.pn * 256 + wc * 32 + 8 * fq;
#pragma unroll
        for (int ai = 0; ai < 2; ++ai)
#pragma unroll
            for (int m = 0; m < 4; ++m)
#pragma unroll
                for (int bj = 0; bj < 2; ++bj) f(row0 + ai * 128 + m * 16, col0 + bj * 128, acc[ai][bj][m][0], acc[ai][bj][m][1]);
    }
    template <class F> __device__ __forceinline__ void loop_rs(const f32x4 (&acc)[2][2][4][2], const pg8::Unit& u, int wr, int wc, int fr, int fq, const float* rowss, const F& f) const {
        const int row0 = u.pm * 256 + wr * 64 + fr, col0 = u.pn * 256 + wc * 32 + 8 * fq;
#pragma unroll
        for (int ai = 0; ai < 2; ++ai)
#pragma unroll
            for (int m = 0; m < 4; ++m) { const int row = row0 + ai * 128 + m * 16; const float rs = __builtin_amdgcn_rsqf(rowss[row] * (1.f / DM) + EPSN);
#pragma unroll
                for (int bj = 0; bj < 2; ++bj) f(row, col0 + bj * 128, acc[ai][bj][m][0] * rs, acc[ai][bj][m][1] * rs); }
    }
    __device__ __forceinline__ void operator()(const f32x4 (&acc)[2][2][4][2], const pg8::Unit& u, int wr, int wc, int fr, int fq) const {
        asm volatile("s_nop 7\n\ts_nop 7\n\ts_nop 7" ::: "memory");
#ifndef EPI_MASK
#define EPI_MASK 0xffff
#endif
#define EPI_ON(k) ((EPI_MASK >> (k)) & 1)
        switch (J.kind) {
        case K_SWIGLU: if (EPI_ON(K_SWIGLU)) { bf16_t* hid = (bf16_t*)J.p0; const float* rowss = J.rowss;
            const int row0 = u.pm * 256 + wr * 64 + fr, hcol = u.pn * 128 + wc * 16 + 4 * (fq & ~1) + 64 * (fq & 1);
#pragma unroll
            for (int ai = 0; ai < 2; ++ai)
#pragma unroll
                for (int m = 0; m < 4; ++m) { const int row = row0 + ai * 128 + m * 16; const float rs = rowss ? __builtin_amdgcn_rsqf(rowss[row] * (1.f / DM) + EPSN) : 1.0f;
                    u32x2 pk[2];
#pragma unroll
                    for (int bj = 0; bj < 2; ++bj) { f32x4 h;
#pragma unroll
                        for (int i = 0; i < 4; ++i) { const float g = acc[ai][bj][m][0][i] * rs, up = acc[ai][bj][m][1][i] * rs; h[i] = g * fsigmoid(g) * up; }
                        pk[bj] = pack4_t(h); }
                    const u32x2 sx = __builtin_amdgcn_permlane16_swap(pk[0].x, pk[1].x, false, false), sy = __builtin_amdgcn_permlane16_swap(pk[0].y, pk[1].y, false, false);
                    const u32x4 o = {sx.x, sy.x, sx.y, sy.y};
                    *(u32x4*)(hid + (size_t)row * FF + hcol) = o; } } break;
        case K_RESID: if (EPI_ON(K_RESID)) { const float* base = (const float*)J.p0; float* out = (float*)J.p1; bf16_t* hb = (bf16_t*)J.p2; float* ssout = J.ssout; const float sc = J.scale;
            const int row0 = u.pm * 256 + wr * 64 + fr, col0 = u.pn * 256 + wc * 32 + 8 * fq;
#pragma unroll
            for (int ai = 0; ai < 2; ++ai)
#pragma unroll
                for (int m = 0; m < 4; ++m) { const int row = row0 + ai * 128 + m * 16; float ss = 0.f;
#pragma unroll
                    for (int bj = 0; bj < 2; ++bj) { const size_t o = (size_t)row * DM + col0 + bj * 128;
                        const f32x4 h0 = *(const f32x4*)(base + o) + acc[ai][bj][m][0] * sc, h1 = *(const f32x4*)(base + o + 4) + acc[ai][bj][m][1] * sc;
                        *(f32x4*)(out + o) = h0; *(f32x4*)(out + o + 4) = h1; *(u32x4*)(hb + o) = pack8(h0, h1);
                        ss += (h0[0] * h0[0] + h0[1] * h0[1]) + (h0[2] * h0[2] + h0[3] * h0[3]) + (h1[0] * h1[0] + h1[1] * h1[1]) + (h1[2] * h1[2] + h1[3] * h1[3]); }
                    ss += __shfl_xor(ss, 16); ss += __shfl_xor(ss, 32);
                    if (fq == 0) atomicAdd(ssout + row, ss); } } break;
        case K_WIN: if (EPI_ON(K_WIN)) {
            unsigned char* const wsb = W.ws;
            bf16_t* const Wq = (bf16_t*)(wsb + WS_Q); bf16_t* const Wvcr = (bf16_t*)(wsb + WS_VCR); bf16_t* const Wcb = (bf16_t*)(wsb + WS_CB); float* const Wgates = (float*)(wsb + WS_GATES); const float* const Wrope = (const float*)(wsb + WS_ROPE);
            loop_rs(acc, u, wr, wc, fr, fq, J.rowss, [=](int row, int col, f32x4 v0, f32x4 v1) {
                const int b = row >> 13, t = row & 8191;
                if (col < 1024) {
                    if (col >= 640 && col < 768) { const int cc = col - 640, g = cc >> 6, d0 = cc & 63;
                        *(u32x4*)(Wvcr + ((size_t)((b * 2 + g) * SEQ + t)) * 64 + d0) = pack8(v0, v1);
                    } else {
                        const int q8 = (col & 63) >> 3;
                        const f32x4 r0 = *(const f32x4*)(Wrope + (size_t)row * 64 + 8 * q8), r1 = *(const f32x4*)(Wrope + (size_t)row * 64 + 8 * q8 + 4);
                        const float c[4] = {r0[0], r0[2], r1[0], r1[2]}, s[4] = {r0[1], r0[3], r1[1], r1[3]};
                        float sc = 1.f; bf16_t* dst;
                        if (col < 512) { dst = Wq + (size_t)row * 512 + (col & ~63) + 4 * q8; sc = QSCALE; }
                        else { const size_t boff = col < 640 ? WS_KCR : (col < 896 ? WS_KS : WS_KW); bf16_t* bp = (bf16_t*)(wsb + boff); const int g = (col >> 6) & 1; dst = bp + ((size_t)((b * 2 + g) * SEQ + t)) * 64 + 4 * q8; }
                        f32x4 o1, o2;
#pragma unroll
                        for (int i = 0; i < 4; ++i) { o1[i] = (v0[i] * c[i] - v1[i] * s[i]) * sc; o2[i] = (v1[i] * c[i] + v0[i] * s[i]) * sc; }
                        *(u32x2*)dst = pack4(o1); *(u32x2*)(dst + 32) = pack4(o2);
                    }
                } else if (col < 2560) { const int cc = col - 1024, which = cc >> 9, c = cc & 511;
                    *(u32x4*)(Wcb + (size_t)which * T * 512 + (size_t)row * 512 + c) = pack8(v0, v1);
                } else { const int cc = col - 2560;
                    if (cc < 24) { float* gp = Wgates + (size_t)row * 24 + cc; *(f32x4*)gp = sig4(v0); *(f32x4*)(gp + 4) = sig4(v1); }
                } }); } break;
        case K_VT: if (EPI_ON(K_VT)) { bf16_t* vt = (bf16_t*)J.p0;
            const float* css = J.rowss;
            loop(acc, u, wr, wc, fr, fq, [=](int row, int col, f32x4 v0, f32x4 v1) { const f32x4 s0 = *(const f32x4*)(css + col), s1 = *(const f32x4*)(css + col + 4);
#pragma unroll
                for (int i = 0; i < 4; ++i) { v0[i] *= __builtin_amdgcn_rsqf(s0[i] * (1.f / DM) + EPSN); v1[i] *= __builtin_amdgcn_rsqf(s1[i] * (1.f / DM) + EPSN); }
                *(u32x4*)(vt + (size_t)row * T + col) = pack8(v0, v1); }); } break;
        case K_GELU: if (EPI_ON(K_GELU)) { bf16_t* out = (bf16_t*)J.p0; const float* bias = (const float*)J.p1;
            loop(acc, u, wr, wc, fr, fq, [=](int row, int col, f32x4 v0, f32x4 v1) { const f32x4 b0 = *(const f32x4*)(bias + col), b1 = *(const f32x4*)(bias + col + 4); f32x4 a, c;
#pragma unroll
                for (int i = 0; i < 4; ++i) { a[i] = gelu_tanh(v0[i] + b0[i]); c[i] = gelu_tanh(v1[i] + b1[i]); }
                *(u32x4*)(out + (size_t)row * 256 + col) = pack8(a, c); }); } break;
        case K_KC: if (EPI_ON(K_KC)) { bf16_t* kc = (bf16_t*)J.p0;
            loop(acc, u, wr, wc, fr, fq, [=](int row, int col, f32x4 v0, f32x4 v1) { if (col < 64) *(u32x4*)(kc + (size_t)row * 64 + col) = pack8(v0, v1); }); } break;
        case K_VCT: if (EPI_ON(K_VCT)) { bf16_t* vct = (bf16_t*)J.p0;
            loop(acc, u, wr, wc, fr, fq, [=](int row, int col, f32x4 v0, f32x4 v1) { if (row < 64) *(u32x4*)(vct + (size_t)row * 4096 + col) = pack8(v0, v1); }); } break;
        case K_PROJA: if (EPI_ON(K_PROJA)) { bf16_t* sg = (bf16_t*)J.p0;
            loop(acc, u, wr, wc, fr, fq, [=](int row, int col, f32x4 v0, f32x4 v1) { const size_t o = (size_t)row * DM + col; f32x4 s0, s1; unpack8(*(const u32x4*)(sg + o), s0, s1);
                *(u32x4*)(sg + o) = pack8(s0 * v0, s1 * v1); }); } break;
        case K_PROJB: if (EPI_ON(K_PROJB)) { bf16_t* sg = (bf16_t*)J.p0; const bf16_t* tmp = (const bf16_t*)J.p1;
            loop(acc, u, wr, wc, fr, fq, [=](int row, int col, f32x4 v0, f32x4 v1) { const size_t o = (size_t)row * DM + col; f32x4 s0, s1, t0, t1; unpack8(*(const u32x4*)(sg + o), s0, s1); unpack8(*(const u32x4*)(tmp + o), t0, t1);
#ifdef X3_GATE_PLUS_HALF
                s0 = s0 + 0.5f; s1 = s1 + 0.5f;
#endif
                *(u32x4*)(sg + o) = pack8(t0 + s0 * v0, t1 + s1 * v1); }); } break;
        case K_SIG: if (EPI_ON(K_SIG)) { bf16_t* sg = (bf16_t*)J.p0;
            loop_rs(acc, u, wr, wc, fr, fq, J.rowss, [=](int row, int col, f32x4 v0, f32x4 v1) {
#ifdef X4_SIG_CONST
                const f32x4 hf = {0.5f, 0.5f, 0.5f, 0.5f}; *(u32x4*)(sg + (size_t)row * DM + col) = pack8(hf + v0 * 0.f, hf + v1 * 0.f);
#else
#ifdef X6_SCALE
                *(u32x4*)(sg + (size_t)row * DM + col) = pack8(sig4(v0 * X6_SCALE), sig4(v1 * X6_SCALE));
#else
                *(u32x4*)(sg + (size_t)row * DM + col) = pack8(sig4(v0), sig4(v1));
#endif
#endif
                }); } break;
        case K_ST32: if (EPI_ON(K_ST32)) { bf16_t* tmp = (bf16_t*)J.p0;
            loop(acc, u, wr, wc, fr, fq, [=](int row, int col, f32x4 v0, f32x4 v1) { *(u32x4*)(tmp + (size_t)row * DM + col) = pack8(v0, v1); }); } break;
        default: if (EPI_ON(K_PLE)) { float* H = (float*)J.p0; const bf16_t* tmp = (const bf16_t*)J.p1;
            loop_rs(acc, u, wr, wc, fr, fq, J.rowss, [=](int row, int col, f32x4 v0, f32x4 v1) { const size_t o = (size_t)row * DM + col;
                f32x4 t0, t1; unpack8(*(const u32x4*)(tmp + o), t0, t1); const f32x4 h0 = *(const f32x4*)(H + o), h1 = *(const f32x4*)(H + o + 4);
                *(f32x4*)(H + o) = h0 + sig4(v0) * t0; *(f32x4*)(H + o + 4) = h1 + sig4(v1) * t1; }); } break;
        }
#if EPI_DRAIN
        asm volatile("s_waitcnt vmcnt(0)" ::: "memory");
#endif
    }
};

__device__ __forceinline__ float wave_sum(float v) {
#pragma unroll
    for (int o = 1; o < 64; o <<= 1) v += __shfl_xor(v, o);
    return v;
}
enum { PK_ID = 0, PK_SWIGLU, PK_WIN, PK_VT, PK_PAD64, PK_GA, PK_GB };
__device__ __forceinline__ int rope_perm(int j) { const int head = j >> 6, jj = j & 63, q8 = jj >> 3, w = jj & 7; return head * 64 + (w < 4 ? 4 * q8 + w : 32 + 4 * q8 + (w - 4)); }
__device__ __forceinline__ int src_col(int pk, int p, int& which) {
    which = 0;
    switch (pk) {
    case PK_ID: return p;
    case PK_SWIGLU: { const int grp = p >> 3, w = p & 7; which = (w >= 4); return grp * 4 + (w & 3); }
    case PK_WIN: {
        if (p < 512) return rope_perm(p);
        if (p < 640) return 512 + rope_perm(p - 512);
        if (p < 768) return p;
        if (p < 896) return 768 + rope_perm(p - 768);
        if (p < 1024) return 1024 + rope_perm(p - 896);
        if (p < 2560) return 1304 + (p - 1024);
        return (p - 2560) < 24 ? 1280 + (p - 2560) : -1; }
    case PK_VT: return p < 128 ? 896 + p : 1152 + (p - 128);
    case PK_GA: return 2840 + p;
    case PK_GB: return 3864 + p;
    default: return p < 64 ? p : -1;
    }
}
__device__ __forceinline__ unsigned f2bf(float f) { unsigned u = __builtin_bit_cast(unsigned, f); return (u + 0x7fffu + ((u >> 16) & 1u)) >> 16; }
__device__ __forceinline__ unsigned pk2(float lo, float hi) { return f2bf(lo) | (f2bf(hi) << 16); }
__device__ __forceinline__ void transpose_item(const float* W0, const float* W1, const float* gain, int K, int N, int pk, bf16_t* WT, LAS float* scr, int item, int nblk, int lane) {
    const int kb = item / nblk, nb = item % nblk, k0 = 64 * kb, p0 = 64 * nb;
    const int cg = lane & 15;
    int which; const int sc = src_col(pk, p0 + 4 * cg, which);
    const float* W = which ? W1 : W0;
    f32x4 v[16];
#pragma unroll
    for (int i = 0; i < 16; ++i) { const int kk = 4 * i + (lane >> 4);
        v[i] = sc >= 0 ? *(const f32x4*)(W + (size_t)(k0 + kk) * N + sc) * (gain ? gain[k0 + kk] : 1.0f) : (f32x4){0.f, 0.f, 0.f, 0.f}; }
#pragma unroll
    for (int i = 0; i < 16; ++i) { const int kk = 4 * i + (lane >> 4); LAS float* d = scr + kk * 65 + 4 * cg; d[0] = v[i][0]; d[1] = v[i][1]; d[2] = v[i][2]; d[3] = v[i][3]; }
    asm volatile("s_waitcnt lgkmcnt(0)" ::: "memory");
    const int c = lane & 7;
#pragma unroll
    for (int j = 0; j < 8; ++j) { const int n = (lane >> 3) + 8 * j; const LAS float* s = scr + (8 * c) * 65 + n;
        u32x4 o; o.x = pk2(s[0 * 65], s[1 * 65]); o.y = pk2(s[2 * 65], s[3 * 65]); o.z = pk2(s[4 * 65], s[5 * 65]); o.w = pk2(s[6 * 65], s[7 * 65]);
        *(u32x4*)(WT + (size_t)(p0 + n) * K + k0 + 8 * c) = o; }
    asm volatile("s_waitcnt lgkmcnt(0)" ::: "memory");
}
template <bool OUT32> __device__ __forceinline__ void norm_row(const float* xrow, const float* gain, void* orow, int lane) {
    const f32x4* xr = (const f32x4*)xrow + lane; const f32x4* gr = (const f32x4*)gain + lane;
    f32x4 v[4]; float s = 0.f;
#pragma unroll
    for (int j = 0; j < 4; ++j) { v[j] = xr[64 * j]; s += (v[j].x * v[j].x + v[j].y * v[j].y) + (v[j].z * v[j].z + v[j].w * v[j].w); }
    const float r = 1.0f / sqrtf(wave_sum(s) * (1.f / DM) + EPSN);
#pragma unroll
    for (int j = 0; j < 4; ++j) { const f32x4 o = v[j] * r * gr[64 * j];
        if (OUT32) ((f32x4*)orow)[lane + 64 * j] = o; else ((u32x2*)orow)[lane + 64 * j] = pack4(o); }
}

template <bool OUT32, int NR> __device__ __forceinline__ void norm_rows_n(const float* xbase, const float* gain, void* obase, int row0, int rstride, int lane) {
    f32x4 v[NR][4];
#pragma unroll
    for (int r = 0; r < NR; ++r) { const f32x4* xr = (const f32x4*)(xbase + (size_t)(row0 + r * rstride) * DM) + lane;
#pragma unroll
        for (int j = 0; j < 4; ++j) v[r][j] = xr[64 * j]; }
    const f32x4* gr = (const f32x4*)gain + lane; f32x4 gv[4];
#pragma unroll
    for (int j = 0; j < 4; ++j) gv[j] = gr[64 * j];
#pragma unroll
    for (int r = 0; r < NR; ++r) { float s = 0.f;
#pragma unroll
        for (int j = 0; j < 4; ++j) s += (v[r][j].x * v[r][j].x + v[r][j].y * v[r][j].y) + (v[r][j].z * v[r][j].z + v[r][j].w * v[r][j].w);
        const float rs = 1.0f / sqrtf(wave_sum(s) * (1.f / DM) + EPSN);
#pragma unroll
        for (int j = 0; j < 4; ++j) { const f32x4 o = v[r][j] * rs * gv[j];
            if (OUT32) ((f32x4*)((float*)obase + (size_t)(row0 + r * rstride) * DM))[lane + 64 * j] = o; else ((u32x2*)((bf16_t*)obase + (size_t)(row0 + r * rstride) * DM))[lane + 64 * j] = pack4(o); } }
}

__device__ __forceinline__ float rows_max(float v) {
    u32x2 r = __builtin_amdgcn_permlane16_swap(__float_as_uint(v), __float_as_uint(v), false, false); v = fmaxf(__uint_as_float(r.x), __uint_as_float(r.y));
    r = __builtin_amdgcn_permlane32_swap(__float_as_uint(v), __float_as_uint(v), false, false); return fmaxf(__uint_as_float(r.x), __uint_as_float(r.y));
}
__device__ __forceinline__ unsigned wave_umax(unsigned v) {
    unsigned t;
    t = (unsigned)__builtin_amdgcn_mov_dpp((int)v, 0xB1, 0xF, 0xF, true); v = t > v ? t : v;
    t = (unsigned)__builtin_amdgcn_mov_dpp((int)v, 0x4E, 0xF, 0xF, true); v = t > v ? t : v;
    t = (unsigned)__builtin_amdgcn_mov_dpp((int)v, 0x141, 0xF, 0xF, true); v = t > v ? t : v;
    t = (unsigned)__builtin_amdgcn_mov_dpp((int)v, 0x140, 0xF, 0xF, true); v = t > v ? t : v;
    u32x2 r = __builtin_amdgcn_permlane16_swap(v, v, false, false); v = r.x > r.y ? r.x : r.y;
    r = __builtin_amdgcn_permlane32_swap(v, v, false, false); return r.x > r.y ? r.x : r.y;
}
__device__ __forceinline__ float rows_sum(float v) {
    u32x2 r = __builtin_amdgcn_permlane16_swap(__float_as_uint(v), __float_as_uint(v), false, false); v = __uint_as_float(r.x) + __uint_as_float(r.y);
    r = __builtin_amdgcn_permlane32_swap(__float_as_uint(v), __float_as_uint(v), false, false); return __uint_as_float(r.x) + __uint_as_float(r.y);
}
constexpr int A_KB = 0, A_VB = 18432, A_IMP = 36864, A_SEL = 104448;
struct AttnP { const bf16_t *q, *kcomp, *vcompT, *ks, *kw, *VT; const float* gates; float* scratch; float* scratch2; bf16_t* onsa; };

template <int MODE>
__device__ __forceinline__ void attn_tile(const LAS unsigned char* Ks, const LAS unsigned char* Vs, const bf16x8 (&qf)[4][2], f32x4 (&O)[4][4], float (&m)[4], float (&l)[4], const float (&invl)[4],
                                          int mmode  , bool track, bool lane_valid, int kbase, int kmax, int kmin, LAS float* imp_row, float& carry, int fr, int fq, int lane) {
    const bool masked = (mmode == 2);
#pragma unroll 1
    for (int ks = 0; ks < 2; ++ks) {
        bf16x8 kf[2][2];
#pragma unroll
        for (int sub = 0; sub < 2; ++sub)
#pragma unroll
            for (int ch = 0; ch < 2; ++ch) kf[sub][ch] = *(const LAS bf16x8*)(Ks + (ks * 32 + sub * 16 + fr) * 144 + ch * 64 + fq * 16);
        f32x4 s[4][2];
#pragma unroll
        for (int hh = 0; hh < 4; ++hh)
#pragma unroll
            for (int sub = 0; sub < 2; ++sub) { f32x4 a = {0.f, 0.f, 0.f, 0.f};
                a = __builtin_amdgcn_mfma_f32_16x16x32_bf16(kf[sub][0], qf[hh][0], a, 0, 0, 0);
                a = __builtin_amdgcn_mfma_f32_16x16x32_bf16(kf[sub][1], qf[hh][1], a, 0, 0, 0); s[hh][sub] = a; }
        if (masked) {
#pragma unroll
            for (int sub = 0; sub < 2; ++sub)
#pragma unroll
                for (int i = 0; i < 4; ++i) { const int kidx = kbase + ks * 32 + sub * 16 + 4 * fq + i; const bool v = lane_valid && kidx <= kmax && kidx > kmin;
#pragma unroll
                    for (int hh = 0; hh < 4; ++hh) s[hh][sub][i] = v ? s[hh][sub][i] : -1e30f; }
        }
        bf16x8 pf[4];
        float ps[2][4] = {{0.f, 0.f, 0.f, 0.f}, {0.f, 0.f, 0.f, 0.f}};
#pragma unroll
        for (int hh = 0; hh < 4; ++hh) {
            f32x4 p0, p1;
            if (MODE != 2) {
                float mn = m[hh], alpha = 1.0f;
                if (track) {
                    float mx = fmaxf(fmaxf(fmaxf(s[hh][0][0], s[hh][0][1]), fmaxf(s[hh][0][2], s[hh][0][3])), fmaxf(fmaxf(s[hh][1][0], s[hh][1][1]), fmaxf(s[hh][1][2], s[hh][1][3])));
                    mx = rows_max(mx);
                    if (mmode == 1) mx = lane_valid ? mx : -1e30f;
                    mn = fmaxf(m[hh], mx); alpha = __builtin_amdgcn_exp2f(m[hh] - mn);
                    m[hh] = mn;
                }
#pragma unroll
                for (int i = 0; i < 4; ++i) { p0[i] = __builtin_amdgcn_exp2f(s[hh][0][i] - mn); p1[i] = __builtin_amdgcn_exp2f(s[hh][1][i] - mn); }
                if (masked) {
#pragma unroll
                    for (int i = 0; i < 4; ++i) { p0[i] = s[hh][0][i] < -1e29f ? 0.f : p0[i]; p1[i] = s[hh][1][i] < -1e29f ? 0.f : p1[i]; }
                }
                if (mmode == 1) { const f32x4 z = {0.f, 0.f, 0.f, 0.f}; p0 = lane_valid ? p0 : z; p1 = lane_valid ? p1 : z; }
                l[hh] = l[hh] * alpha + ((p0[0] + p0[1]) + (p0[2] + p0[3])) + ((p1[0] + p1[1]) + (p1[2] + p1[3]));
                if (MODE == 1 && track) { if (__builtin_amdgcn_ballot_w64(alpha != 1.0f) != 0ull) {
#pragma unroll
                    for (int dt = 0; dt < 4; ++dt) O[hh][dt] = O[hh][dt] * alpha; } }
            } else {
                const float mh = m[hh], il = invl[hh];
#pragma unroll
                for (int i = 0; i < 4; ++i) { p0[i] = __builtin_amdgcn_exp2f(s[hh][0][i] - mh) * il; p1[i] = __builtin_amdgcn_exp2f(s[hh][1][i] - mh) * il; }
                if (masked) {
#pragma unroll
                    for (int i = 0; i < 4; ++i) { p0[i] = s[hh][0][i] < -1e29f ? 0.f : p0[i]; p1[i] = s[hh][1][i] < -1e29f ? 0.f : p1[i]; }
                }
#pragma unroll
                for (int i = 0; i < 4; ++i) { ps[0][i] += p0[i]; ps[1][i] += p1[i]; }
            }
            if (MODE != 0) { const u32x4 w = pack8(p0, p1); pf[hh] = __builtin_bit_cast(bf16x8, w); }
        }
        if (MODE == 2) {
            const float a0 = ps[0][0] + ps[0][1] + ps[0][2] + 0.5f * ps[0][3], b0 = 0.5f * ps[0][3];
            const float a1 = ps[1][0] + ps[1][1] + ps[1][2] + 0.5f * ps[1][3], b1 = 0.5f * ps[1][3];
            const int src = (lane - 16) & 63;
            const float x0 = __shfl(b0, src), x1 = __shfl(b1, src);
            const int sa = (kbase + ks * 32) / 4 + fq;
            imp_row[sa] = a0 + (fq > 0 ? x0 : carry);
            imp_row[sa + 4] = a1 + (fq > 0 ? x1 : x0);
            carry = x1;
        }
        if (MODE != 0) {
#pragma unroll
            for (int dt = 0; dt < 4; ++dt) {
                const u32x2 v0 = *(const LAS u32x2*)(Vs + (dt * 16 + fr) * 144 + ks * 64 + fq * 8), v1 = *(const LAS u32x2*)(Vs + (dt * 16 + fr) * 144 + ks * 64 + 32 + fq * 8);
                const u32x4 vv = {v0.x, v0.y, v1.x, v1.y}; const bf16x8 vf = __builtin_bit_cast(bf16x8, vv);
#pragma unroll
                for (int hh = 0; hh < 4; ++hh) O[hh][dt] = __builtin_amdgcn_mfma_f32_16x16x32_bf16(vf, pf[hh], O[hh][dt], 0, 0, 0);
            }
        }
    }
}

template <int BR>
__device__ __forceinline__ void run_branch(LAS unsigned char* lds, const bf16_t* Kg, const bf16_t* Vg, int ldv, int jlo, int jhi, const bf16x8 (&qf)[4][2], f32x4 (&O)[4][4], float (&m)[4], float (&l)[4],
                                           const float (&invl)[4], int tid, int w, int lane, int fr, int fq, int qlo, int tq, int blkq, unsigned long long sel_lo, unsigned long long sel_hi) {
    constexpr int MODE = (BR == 0) ? 0 : (BR == 1 ? 2 : 1);
    const int lrow = tid >> 3, lch = tid & 7;
    u32x4 kr, vr;
#define A_GLOAD(j) do { kr = *(const u32x4*)(Kg + (size_t)(64 * (j) + lrow) * 64 + lch * 8); vr = *(const u32x4*)(Vg + (size_t)lrow * ldv + 64 * (j) + lch * 8); } while (0)
#define A_LSTORE(buf) do { *(LAS u32x4*)(lds + A_KB + (buf) * 9216 + lrow * 144 + lch * 16) = kr; *(LAS u32x4*)(lds + A_VB + (buf) * 9216 + lrow * 144 + lch * 16) = vr; } while (0)
    A_GLOAD(jlo); A_LSTORE(0); __syncthreads();
    float carry = 0.f;
    LAS float* imp_row = (LAS float*)(lds + A_IMP) + (w * 16 + fr) * 132;
    for (int j = jlo; j <= jhi; ++j) {
        const int cur = (j - jlo) & 1;
        if (j < jhi) A_GLOAD(j + 1);
        bool skip = false, masked = false, lane_valid = true; int kmax = 0x7fffffff, kmin = -1;
        if (BR <= 1) { const int lim_lo = (qlo - 31) >> 4, lim_hi = (qlo + 15 - 31) >> 4; kmax = (tq - 31) >> 4; masked = (64 * j + 63 > lim_lo); skip = (BR == 0) && (64 * j > lim_hi); }
        if (BR == 2) { lane_valid = (((j < 64 ? sel_lo : sel_hi) >> (j & 63)) & 1ull) != 0ull; const unsigned long long bal = __builtin_amdgcn_ballot_w64(lane_valid);
            skip = (j > blkq) || (bal == 0ull); masked = (j == blkq) || (bal != ~0ull); kmax = (j == blkq) ? tq : 0x7fffffff; }
        if (BR == 3) { skip = (64 * j > qlo + 15) || (64 * j + 63 <= qlo - 512); masked = (64 * j + 63 > qlo) || (64 * j <= qlo + 15 - 512); kmax = tq; kmin = tq - 512; }
        int mmode = masked ? 2 : 0;
        const bool track = (MODE != 1) || (__builtin_amdgcn_ballot_w64(m[0] < -1e29f) != 0ull);
        if (BR == 2) mmode = (j == blkq) ? 2 : (masked ? 1 : 0);
        if (!skip) attn_tile<MODE>(lds + A_KB + cur * 9216, lds + A_VB + cur * 9216, qf, O, m, l, invl, mmode, track, lane_valid, 64 * j, kmax, kmin, imp_row, carry, fr, fq, lane);
        if (j < jhi) A_LSTORE(cur ^ 1);
        __syncthreads();
    }
#undef A_GLOAD
#undef A_LSTORE
}


__device__ __forceinline__ void run_branch_sel(LAS unsigned char* lds, const bf16_t* Kg, const bf16_t* Vg, int ldv, int jhi, const bf16_t* qbase  ,
                                               const float* gbase  , bf16_t* obase  ,
                                               int tid, int w, int lane, int fr, int fq, int qlo, int blkq) {
    const int lrow = tid >> 3, lch = tid & 7;
    const int ql = fr >> 2, hl = fr & 3;
    bf16x8 qf[4][2]; f32x4 O[4][4]; float m[4], l[4];
#pragma unroll
    for (int gi = 0; gi < 4; ++gi) { m[gi] = -1e30f; l[gi] = 0.f;
#pragma unroll
        for (int ch = 0; ch < 2; ++ch) qf[gi][ch] = *(const bf16x8*)(qbase + (size_t)(gi * 4 + ql) * 512 + hl * 64 + ch * 32 + fq * 8);
#pragma unroll
        for (int dt = 0; dt < 4; ++dt) O[gi][dt] = (f32x4){0.f, 0.f, 0.f, 0.f}; }
    const LAS unsigned* selw = (const LAS unsigned*)(lds + A_SEL) + (w * 16 + ql) * 4;
    u32x4 kr, vr;
#define S_GLOAD(j) do { kr = *(const u32x4*)(Kg + (size_t)(64 * (j) + lrow) * 64 + lch * 8); vr = *(const u32x4*)(Vg + (size_t)lrow * ldv + 64 * (j) + lch * 8); } while (0)
#define S_LSTORE(buf) do { *(LAS u32x4*)(lds + A_KB + (buf) * 9216 + lrow * 144 + lch * 16) = kr; *(LAS u32x4*)(lds + A_VB + (buf) * 9216 + lrow * 144 + lch * 16) = vr; } while (0)
    S_GLOAD(0); S_LSTORE(0); __syncthreads();
    unsigned selreg[4] = {0u, 0u, 0u, 0u};
    for (int j = 0; j <= jhi; ++j) {
        const int cur = j & 1;
        if ((j & 31) == 0) {
#pragma unroll
            for (int gi = 0; gi < 4; ++gi) selreg[gi] = selw[gi * 16 + (j >> 5)]; }
        if (j < jhi) S_GLOAD(j + 1);
        if (j <= blkq) {
            const LAS unsigned char* Ks = lds + A_KB + cur * 9216; const LAS unsigned char* Vs = lds + A_VB + cur * 9216;
            bool lv[4]; unsigned long long bal[4]; bool anyg = false;
#pragma unroll
            for (int gi = 0; gi < 4; ++gi) { lv[gi] = ((selreg[gi] >> (j & 31)) & 1u) != 0u; bal[gi] = __builtin_amdgcn_ballot_w64(lv[gi]); anyg = anyg || (bal[gi] != 0ull); }
            if (anyg) {
#pragma unroll
                for (int ks = 0; ks < 2; ++ks) {
                    bf16x8 kf[2][2], vf[4];
#pragma unroll
                    for (int sub = 0; sub < 2; ++sub)
#pragma unroll
                        for (int ch = 0; ch < 2; ++ch) kf[sub][ch] = *(const LAS bf16x8*)(Ks + (ks * 32 + sub * 16 + fr) * 144 + ch * 64 + fq * 16);
#pragma unroll
                    for (int dt = 0; dt < 4; ++dt) { const u32x2 v0 = *(const LAS u32x2*)(Vs + (dt * 16 + fr) * 144 + ks * 64 + fq * 8), v1 = *(const LAS u32x2*)(Vs + (dt * 16 + fr) * 144 + ks * 64 + 32 + fq * 8);
                        const u32x4 vv = {v0.x, v0.y, v1.x, v1.y}; vf[dt] = __builtin_bit_cast(bf16x8, vv); }
#pragma unroll
                    for (int gi = 0; gi < 4; ++gi) {
                        if (bal[gi] != 0ull) {
                            f32x4 s0 = {0.f, 0.f, 0.f, 0.f}, s1 = {0.f, 0.f, 0.f, 0.f};
                            s0 = __builtin_amdgcn_mfma_f32_16x16x32_bf16(kf[0][0], qf[gi][0], s0, 0, 0, 0); s0 = __builtin_amdgcn_mfma_f32_16x16x32_bf16(kf[0][1], qf[gi][1], s0, 0, 0, 0);
                            s1 = __builtin_amdgcn_mfma_f32_16x16x32_bf16(kf[1][0], qf[gi][0], s1, 0, 0, 0); s1 = __builtin_amdgcn_mfma_f32_16x16x32_bf16(kf[1][1], qf[gi][1], s1, 0, 0, 0);
                            const bool alllv = (bal[gi] == ~0ull);
                            if (j == blkq) {
                                const int tqg = qlo + gi * 4 + ql;
#pragma unroll
                                for (int i = 0; i < 4; ++i) { const int k0 = 64 * j + ks * 32 + 4 * fq + i; s0[i] = (k0 <= tqg) ? s0[i] : -1e30f; s1[i] = (k0 + 16 <= tqg) ? s1[i] : -1e30f; }
                            }
                            float mn = m[gi], alpha = 1.0f;
                            const bool track = __builtin_amdgcn_ballot_w64(m[gi] < -1e29f) != 0ull;
                            if (track) {
                                float mx = fmaxf(fmaxf(fmaxf(s0[0], s0[1]), fmaxf(s0[2], s0[3])), fmaxf(fmaxf(s1[0], s1[1]), fmaxf(s1[2], s1[3])));
                                mx = rows_max(mx); mx = lv[gi] ? mx : -1e30f;
                                mn = fmaxf(m[gi], mx); alpha = __builtin_amdgcn_exp2f(m[gi] - mn); m[gi] = mn;
                            }
                            f32x4 p0, p1;
#pragma unroll
                            for (int i = 0; i < 4; ++i) { p0[i] = __builtin_amdgcn_exp2f(s0[i] - mn); p1[i] = __builtin_amdgcn_exp2f(s1[i] - mn); }
                            if (j == blkq) {
#pragma unroll
                                for (int i = 0; i < 4; ++i) { p0[i] = s0[i] < -1e29f ? 0.f : p0[i]; p1[i] = s1[i] < -1e29f ? 0.f : p1[i]; }
                            }
                            if (!alllv) { const f32x4 z = {0.f, 0.f, 0.f, 0.f}; p0 = lv[gi] ? p0 : z; p1 = lv[gi] ? p1 : z; }
                            l[gi] = l[gi] * alpha + ((p0[0] + p0[1]) + (p0[2] + p0[3])) + ((p1[0] + p1[1]) + (p1[2] + p1[3]));
                            if (track) { if (__builtin_amdgcn_ballot_w64(alpha != 1.0f) != 0ull) {
#pragma unroll
                                for (int dt = 0; dt < 4; ++dt) O[gi][dt] = O[gi][dt] * alpha; } }
                            const u32x4 pw = pack8(p0, p1); const bf16x8 pf = __builtin_bit_cast(bf16x8, pw);
#pragma unroll
                            for (int dt = 0; dt < 4; ++dt) O[gi][dt] = __builtin_amdgcn_mfma_f32_16x16x32_bf16(vf[dt], pf, O[gi][dt], 0, 0, 0);
                        }
                    }
                }
            }
        }
        if (j < jhi) S_LSTORE(cur ^ 1);
        __syncthreads();
    }
#undef S_GLOAD
#undef S_LSTORE
#pragma unroll
    for (int gi = 0; gi < 4; ++gi) { const float lt = rows_sum(l[gi]); const float gt = lt > 0.f ? gbase[(size_t)(gi * 4 + ql) * 24 + hl * 3 + 1] / lt : 0.f;
        bf16_t* op = obase + (size_t)(gi * 4 + ql) * 512 + hl * 64 + 4 * fq;
#pragma unroll
        for (int dt = 0; dt < 4; ++dt) *(u32x2*)(op + dt * 16) = pack4(O[gi][dt] * gt); }
}

__device__ __forceinline__ void attn_unit(LAS unsigned char* lds, const AttnP& P, int b, int g, int iu, int tid, int w, int lane) {
    const int fr = lane & 15, fq = lane >> 4;
    const int t0 = iu * 128, qlo = t0 + 16 * w, tq = qlo + fr, blkq = qlo >> 6;
    const size_t rowq = (size_t)b * SEQ + tq;
#define A_STATE() bf16x8 qf[4][2]; f32x4 O[4][4]; float m[4], l[4], invl[4]; \
    _Pragma("unroll") for (int hh = 0; hh < 4; ++hh) _Pragma("unroll") for (int ch = 0; ch < 2; ++ch) qf[hh][ch] = *(const bf16x8*)(P.q + rowq * 512 + (g * 4 + hh) * 64 + ch * 32 + fq * 8)
#define A_RESET() do { _Pragma("unroll") for (int hh = 0; hh < 4; ++hh) { m[hh] = -1e30f; l[hh] = 0.f; invl[hh] = 0.f; _Pragma("unroll") for (int dt = 0; dt < 4; ++dt) O[hh][dt] = (f32x4){0.f, 0.f, 0.f, 0.f}; } } while (0)
#define A_FINL() do { _Pragma("unroll") for (int hh = 0; hh < 4; ++hh) { float lt = rows_sum(l[hh]); invl[hh] = lt > 0.f ? 1.0f / lt : 0.f; } } while (0)
    const int bg = b * 2 + g;
#define A_PTRS() size_t rq_ = rowq; asm volatile("" : "+v"(rq_)); float* scr = P.scratch + rq_ * 512 + g * 256 + 4 * fq; const float* gp = P.gates + rq_ * 24 + g * 12
    { A_STATE();
    {
        const bf16_t* Kc = P.kcomp + (size_t)(bg * 512) * 64; const bf16_t* Vc = P.vcompT + bg * 512;
        const int ntc = (8 * iu + 7 + 63) >> 6;
        A_RESET();
        run_branch<0>(lds, Kc, Vc, 4096, 0, ntc - 1, qf, O, m, l, invl, tid, w, lane, fr, fq, qlo, tq, blkq, 0ull, 0ull);
        A_FINL();
        run_branch<1>(lds, Kc, Vc, 4096, 0, ntc - 1, qf, O, m, l, invl, tid, w, lane, fr, fq, qlo, tq, blkq, 0ull, 0ull);
    }
    {
        LAS float* impw = (LAS float*)(lds + A_IMP) + (w * 16) * 132;
        LAS unsigned* sel = (LAS unsigned*)(lds + A_SEL) + (w * 16) * 4;
        for (int qi = 0; qi < 8; ++qi) {
            unsigned long long loA, hiA = 0ull, loB, hiB = 0ull;
            if (blkq + 1 <= 16) { loA = (2ull << blkq) - 1ull; loB = loA; }
            else {
                loA = 1ull;
                { const int s1 = blkq - 1, s2 = blkq; if (s1 < 64) loA |= 1ull << s1; else hiA |= 1ull << (s1 - 64); if (s2 < 64) loA |= 1ull << s2; else hiA |= 1ull << (s2 - 64); }
                loB = loA; hiB = hiA;
                const float a0 = impw[qi * 132 + lane], a1 = impw[qi * 132 + 64 + lane], b0 = impw[(qi + 8) * 132 + lane], b1 = impw[(qi + 8) * 132 + 64 + lane];
                const bool c0 = (lane >= 1 && lane <= blkq - 2), c1 = (lane + 64 <= blkq - 2);
                unsigned ka0 = c0 ? ((__float_as_uint(a0) & ~127u) | (unsigned)(127 - lane)) : 0u, ka1 = c1 ? ((__float_as_uint(a1) & ~127u) | (unsigned)(63 - lane)) : 0u;
                unsigned kb0 = c0 ? ((__float_as_uint(b0) & ~127u) | (unsigned)(127 - lane)) : 0u, kb1 = c1 ? ((__float_as_uint(b1) & ~127u) | (unsigned)(63 - lane)) : 0u;
                for (int r = 0; r < 13; ++r) {
                    unsigned bestA = ka0 > ka1 ? ka0 : ka1, bestB = kb0 > kb1 ? kb0 : kb1;
                    bestA = wave_umax(bestA); bestB = wave_umax(bestB);
                    bestA = (unsigned)__builtin_amdgcn_readfirstlane((int)bestA); bestB = (unsigned)__builtin_amdgcn_readfirstlane((int)bestB);
                    const int sA = 127 - (int)(bestA & 127u), sB = 127 - (int)(bestB & 127u);
                    if (sA < 64) loA |= 1ull << sA; else hiA |= 1ull << (sA - 64);
                    if (sB < 64) loB |= 1ull << sB; else hiB |= 1ull << (sB - 64);
                    if (ka0 == bestA) ka0 = 0u; if (ka1 == bestA) ka1 = 0u; if (kb0 == bestB) kb0 = 0u; if (kb1 == bestB) kb1 = 0u;
                }
            }
            if (lane == 0) { sel[qi * 4 + 0] = (unsigned)loA; sel[qi * 4 + 1] = (unsigned)(loA >> 32); sel[qi * 4 + 2] = (unsigned)hiA; sel[qi * 4 + 3] = (unsigned)(hiA >> 32);
                             sel[(qi + 8) * 4 + 0] = (unsigned)loB; sel[(qi + 8) * 4 + 1] = (unsigned)(loB >> 32); sel[(qi + 8) * 4 + 2] = (unsigned)hiB; sel[(qi + 8) * 4 + 3] = (unsigned)(hiB >> 32); }
        }
    }
    { A_PTRS();
#pragma unroll
    for (int hh = 0; hh < 4; ++hh) { const float gt = gp[hh * 3 + 0];
#pragma unroll
        for (int dt = 0; dt < 4; ++dt) *(f32x4*)(scr + hh * 64 + dt * 16) = O[hh][dt] * gt; } }
    }
    {
        const bf16_t* Kg = P.ks + (size_t)(bg * SEQ) * 64; const bf16_t* Vg = P.VT + (size_t)(g * 64) * T + (size_t)b * SEQ;
        const size_t r0 = (size_t)b * SEQ + qlo;
        run_branch_sel(lds, Kg, Vg, T, 2 * iu + 1, P.q + r0 * 512 + g * 256, P.gates + r0 * 24 + g * 12, P.onsa + r0 * 512 + g * 256, tid, w, lane, fr, fq, qlo, blkq);
    }
    {
        A_STATE();
        const bf16_t* Kg = P.kw + (size_t)(bg * SEQ) * 64; const bf16_t* Vg = P.VT + (size_t)(128 + g * 64) * T + (size_t)b * SEQ;
        A_RESET();
        const int jlo = 2 * iu - 8 < 0 ? 0 : 2 * iu - 8;
        run_branch<3>(lds, Kg, Vg, T, jlo, 2 * iu + 1, qf, O, m, l, invl, tid, w, lane, fr, fq, qlo, tq, blkq, 0ull, 0ull);
        A_FINL();
        A_PTRS(); bf16_t* op = P.onsa + rq_ * 512 + g * 256 + 4 * fq;
#pragma unroll
        for (int hh = 0; hh < 4; ++hh) { const float gt = gp[hh * 3 + 2] * invl[hh];
#pragma unroll
            for (int dt = 0; dt < 4; ++dt) { const u32x2 pk_ = *(const u32x2*)(op + hh * 64 + dt * 16); const f32x4 sel_ = {bf_lo(pk_.x), bf_hi(pk_.x), bf_lo(pk_.y), bf_hi(pk_.y)};
                const f32x4 r = *(const f32x4*)(scr + hh * 64 + dt * 16) + sel_ + O[hh][dt] * gt; *(u32x2*)(op + hh * 64 + dt * 16) = pack4(r); } }
    }
#undef A_STATE
#undef A_PTRS
#undef A_RESET
#undef A_FINL
}

#define XB_TMO      128
#define XB_XCNT(j)  (256  + 64 * (j))
#define XB_XSUB(j)  (1280 + 64 * (j))
#define XB_XGEN(j)  (2304 + 64 * (j))
#define XB_TOP      3328
#define XB_TOPGEN   3392
#define XCD_BAR_WORDS 3456
#define XB_SPIN_CAP (1u << 18)

__device__ __forceinline__ unsigned xb_ld(unsigned* p)              { return __hip_atomic_load(p, __ATOMIC_RELAXED, __HIP_MEMORY_SCOPE_AGENT); }
__device__ __forceinline__ unsigned xb_add(unsigned* p, unsigned v) { return __hip_atomic_fetch_add(p, v, __ATOMIC_RELAXED, __HIP_MEMORY_SCOPE_AGENT); }
__device__ __forceinline__ unsigned xb_xcc_id() { return (unsigned)__builtin_amdgcn_s_getreg((3 << 11) | 20) & 0xFu; }
#define XB_SPIN(cond, bar) do { unsigned _sp = 0; while (cond) { __builtin_amdgcn_s_sleep(1); \
    if ((++_sp & 255u) == 0u) { if (xb_ld(&(bar)[XB_TMO])) break; if (_sp > XB_SPIN_CAP) { atomicAdd(&(bar)[XB_TMO], 1u); break; } } } } while (0)

struct XcdBarrier {
    unsigned* bar; unsigned x;
    volatile LAS unsigned* st;
};

__device__ __forceinline__ XcdBarrier xcd_barrier_post(unsigned* bar, volatile LAS unsigned* st) {
    XcdBarrier b; b.bar = bar; b.x = xb_xcc_id(); b.st = st;
    if (threadIdx.x == 0) (void)xb_add(&bar[XB_XCNT(b.x)], 1u);
    return b;
}
__device__ __forceinline__ void xcd_barrier_complete(unsigned* bar, unsigned x, unsigned& nloc, unsigned& nx) {
    const unsigned G = gridDim.x * gridDim.y * gridDim.z;
    unsigned sum, cnt, mine, sp = 0u;
    for (;;) {
        sum = 0u; cnt = 0u; mine = 0u;
#pragma unroll
        for (unsigned j = 0; j < 16; ++j) { const unsigned c = xb_ld(&bar[XB_XCNT(j)]); sum += c; cnt += (c > 0u) ? 1u : 0u; mine = (j == x) ? c : mine; }
        if (sum == G) break;
        __builtin_amdgcn_s_sleep(1);
        if ((++sp & 255u) == 0u) { if (xb_ld(&bar[XB_TMO])) break; if (sp > XB_SPIN_CAP) { atomicAdd(&bar[XB_TMO], 1u); break; } }
    }
    nloc = mine > 0u ? mine : 1u; nx = cnt > 0u ? cnt : 1u;
}

__device__ __forceinline__ void xcd_barrier(const XcdBarrier& b) {
    asm volatile("s_waitcnt vmcnt(0)" ::: "memory");
    __syncthreads();
    if (threadIdx.x == 0) {
        unsigned* bar = b.bar;
        __builtin_amdgcn_s_waitcnt(0);
        unsigned nloc = b.st[0], nx = b.st[1];
        if (nloc == 0u) { xcd_barrier_complete(bar, b.x, nloc, nx); b.st[0] = nloc; b.st[1] = nx; }
        const unsigned old = xb_add(&bar[XB_XSUB(b.x)], 1u);
        const unsigned gen = old / nloc;
        if (old + 1u == (gen + 1u) * nloc) {
            __builtin_amdgcn_fence(__ATOMIC_RELEASE, "agent");
            asm volatile("s_waitcnt vmcnt(0)" ::: "memory");
            const unsigned og = xb_add(&bar[XB_TOP], 1u);
            const unsigned tg = og / nx;
            if (og + 1u == (tg + 1u) * nx) xb_add(&bar[XB_TOPGEN], 1u);
            else XB_SPIN(xb_ld(&bar[XB_TOPGEN]) == tg, bar);
            __builtin_amdgcn_fence(__ATOMIC_ACQUIRE, "agent");
            xb_add(&bar[XB_XGEN(b.x)], 1u);
            asm volatile("s_waitcnt vmcnt(0)" ::: "memory");
        } else {
            XB_SPIN(xb_ld(&bar[XB_XGEN(b.x)]) == gen, bar);
            __builtin_amdgcn_fence(__ATOMIC_ACQUIRE, "agent");
            asm volatile("s_waitcnt vmcnt(0)" ::: "memory");
        }
    }
    __syncthreads();
}

struct Args { const void* in[30]; float* out; unsigned char* ws; double invf[32]; int ph_lo, ph_hi; };

enum { PH_PRO = 0, PH_F1UP, PH_F1DN, PH_WIN, PH_WVT, PH_C1K, PH_C2K, PH_C1V, PH_C2V, PH_CONV, PH_PCONV, PH_ATTN, PH_GA, PH_PA, PH_GB, PH_PB, PH_WO, PH_F2UP, PH_F2DN, PH_PP, PH_PG, PH_FNORM, PH_N };
__host__ __device__ inline bool sync_after(int k) { return !(k == PH_WIN || k == PH_C1K || k == PH_C1V || k == PH_C2K || k == PH_C2V || k == PH_CONV || k == PH_GA || k == PH_PA || (k == PH_GB && !(DBG_GATE >= 1 && DBG_GATE <= 4)) || k == PH_PP || k == PH_FNORM); }

__global__ void __launch_bounds__(512, 2) fwd_kernel(Args a) {
    extern __shared__ __attribute__((aligned(16))) unsigned char lds_raw[];
    LAS unsigned char* lds = (LAS unsigned char*)lds_raw;
    const int G = gridDim.x, bid = blockIdx.x, NGW = G * NWAVES;
    unsigned char* ws = a.ws;
    const float* x = (const float*)a.in[0]; const float* pin = (const float*)a.in[1]; const int* positions = (const int*)a.in[2];
    float* H = (float*)(ws + WS_H); bf16_t* U = (bf16_t*)(ws + WS_U); bf16_t* HID = (bf16_t*)(ws + WS_BIG);

#if !SPLIT_LAUNCH
    volatile LAS unsigned* bar_st = (volatile LAS unsigned*)(lds + 139264);
    if (threadIdx.x < 2) bar_st[threadIdx.x] = 0u;
    __syncthreads();
    XcdBarrier xbar = xcd_barrier_post((unsigned*)ws + 1024, bar_st);
#endif
#ifndef REP_PRO_N
#define REP_PRO_N 0
#endif
#ifndef PRO_SKIP_T
#define PRO_SKIP_T 0
#endif
    for (int it_ = a.ph_lo - REP_PRO_N; it_ < a.ph_hi; ++it_) { const int ph = it_ < 0 ? 0 : it_;
        int tid = threadIdx.x; asm volatile("" : "+v"(tid));
        const int lane = tid & 63, wave = __builtin_amdgcn_readfirstlane(tid >> 6), gw = bid * NWAVES + wave;
        Job J; J.A = nullptr; J.Bt = nullptr; J.M = 0; J.N = 0; J.K = 0; J.lda = 0; J.kind = -1; J.rot = 0; J.p0 = nullptr; J.p1 = nullptr; J.p2 = nullptr; J.scale = 1.f;
        switch (ph) {
        case PH_F1UP: J.A = U; J.Bt = (bf16_t*)(ws + WS_F1UP); J.M = T; J.N = 2 * FF; J.K = DM; J.lda = DM; J.kind = K_SWIGLU; J.p0 = HID; break;
        case PH_F1DN: J.A = HID; J.Bt = (bf16_t*)(ws + WS_F1DN); J.M = T; J.N = DM; J.K = FF; J.lda = FF; J.kind = K_RESID; J.p0 = (void*)x; J.p1 = H; J.scale = 0.5f; break;
        case PH_WIN: J.A = U; J.Bt = (bf16_t*)(ws + WS_WIN); J.M = T; J.N = 2816; J.K = DM; J.lda = DM; J.kind = K_WIN; break;
        case PH_WVT: J.A = (bf16_t*)(ws + WS_WVT); J.Bt = U; J.M = 256; J.N = T; J.K = DM; J.lda = DM; J.kind = K_VT; J.rot = 128; J.p0 = ws + WS_VT; break;
        case PH_C1K: J.A = (bf16_t*)(ws + WS_KCR); J.Bt = (bf16_t*)(ws + WS_CK1); J.M = 4096; J.N = 256; J.K = 2048; J.lda = 1024; J.kind = K_GELU; J.p0 = ws + WS_HCK; J.p1 = ws + WS_BIASK; break;
        case PH_C1V: J.A = (bf16_t*)(ws + WS_VCR); J.Bt = (bf16_t*)(ws + WS_CV1); J.M = 4096; J.N = 256; J.K = 2048; J.lda = 1024; J.kind = K_GELU; J.rot = 16; J.p0 = ws + WS_HCV; J.p1 = ws + WS_BIASV; break;
        case PH_C2K: J.A = (bf16_t*)(ws + WS_HCK); J.Bt = (bf16_t*)(ws + WS_CK2); J.M = 4096; J.N = 256; J.K = 256; J.lda = 256; J.kind = K_KC; J.p0 = ws + WS_KCOMP; break;
        case PH_C2V: J.A = (bf16_t*)(ws + WS_CV2); J.Bt = (bf16_t*)(ws + WS_HCV); J.M = 256; J.N = 4096; J.K = 256; J.lda = 256; J.kind = K_VCT; J.rot = 16; J.p0 = ws + WS_VCOMPT; break;
        case PH_GA: J.A = U; J.Bt = (bf16_t*)(ws + WS_WGA); J.M = T; J.N = DM; J.K = DM; J.lda = DM; J.kind = K_SIG; J.p0 = ws + WS_SGA; break;
        case PH_PA: J.A = (bf16_t*)(ws + WS_ONSA); J.Bt = (bf16_t*)(ws + WS_PA); J.M = T; J.N = DM; J.K = 512; J.lda = 512; J.kind = K_PROJA; J.p0 = ws + WS_SGA; break;
        case PH_GB: J.A = U; J.Bt = (bf16_t*)(ws + WS_WGB); J.M = T; J.N = DM; J.K = DM; J.lda = DM; J.kind = K_SIG; J.p0 = ws + WS_SGB; break;
        case PH_PB: J.A = (bf16_t*)(ws + WS_OCONV); J.Bt = (bf16_t*)(ws + WS_PB); J.M = T; J.N = DM; J.K = 512; J.lda = 512; J.kind = K_PROJB; J.p0 = ws + WS_SGB; J.p1 = ws + WS_SGA; break;
        case PH_WO: J.A = (bf16_t*)(ws + WS_SGB); J.Bt = (bf16_t*)(ws + WS_WO); J.M = T; J.N = DM; J.K = DM; J.lda = DM; J.kind = K_RESID; J.p0 = H; J.p1 = H; J.scale = 1.f; break;
        case PH_F2UP: J.A = U; J.Bt = (bf16_t*)(ws + WS_F2UP); J.M = T; J.N = 2 * FF; J.K = DM; J.lda = DM; J.kind = K_SWIGLU; J.p0 = HID; break;
        case PH_F2DN: J.A = HID; J.Bt = (bf16_t*)(ws + WS_F2DN); J.M = T; J.N = DM; J.K = FF; J.lda = FF; J.kind = K_RESID; J.p0 = H; J.p1 = H; J.scale = 0.5f; break;
        case PH_PP: J.A = (bf16_t*)(ws + WS_PBF); J.Bt = (bf16_t*)(ws + WS_PP); J.M = T; J.N = DM; J.K = 256; J.lda = 256; J.kind = K_ST32; J.p0 = ws + WS_TMP; break;
        case PH_PG: J.A = U; J.Bt = (bf16_t*)(ws + WS_PG); J.M = T; J.N = DM; J.K = DM; J.lda = DM; J.kind = K_PLE; J.p0 = H; J.p1 = ws + WS_TMP; break;
        default: break;
        }
        J.rowss = nullptr; J.ssout = nullptr;
        { float* ssq = (float*)(ws + WS_SUMSQ);
          switch (ph) {
          case PH_F1DN: J.p2 = U; J.ssout = ssq; break;
          case PH_WIN: case PH_WVT: case PH_GA: case PH_GB: J.rowss = ssq; break;
          case PH_WO: J.p2 = U; J.ssout = ssq + T; break;
          case PH_F2UP: J.rowss = ssq + T; break;
          case PH_F2DN: J.p2 = U; J.ssout = ssq + 2 * T; break;
          case PH_PG: J.rowss = ssq + 2 * T; break;
          default: break; } }
#if DBG_GATE
        if (ph == PH_PRO && bid == 0 && tid == 0) { *(unsigned*)ws = 0u; ((unsigned*)ws)[1] = 0u; }
#if DBG_GATE == 2
        if (ph == PH_C1K && bid < 4) {
            const int sidx = bid * 512 + tid; const int row = (int)(((long long)sidx * 7919) % T), col = (int)(((long long)sidx * 104729) % 512);
            const float* win = (const float*)a.in[8]; float g = 0.f;
            for (int k = 0; k < DM; ++k) { const float wv = __uint_as_float(f2bf(win[(size_t)k * WIN_COLS + 1304 + col]) << 16); g += __uint_as_float((unsigned)U[(size_t)row * DM + k] << 16) * wv; }
            const float got = __uint_as_float((unsigned)((const bf16_t*)(ws + WS_CB))[(size_t)row * 512 + col] << 16);
            if (!(fabsf(g - got) < 0.03f + 0.01f * fabsf(g))) { atomicOr((unsigned*)ws, 1u); atomicAdd((unsigned*)ws + 1, 1u); }
        }
#endif
#if DBG_GATE == 5
        if (ph == PH_WO && bid < 4) {
            const int sidx = bid * 512 + tid; const int row = (int)(((long long)sidx * 7919) % T), col = (int)(((long long)sidx * 104729) % 1024);
            const float* win = (const float*)a.in[8]; const float* wb = (const float*)a.in[20]; float g = 0.f, v = 0.f;
            for (int k = 0; k < DM; ++k) { const float wv = __uint_as_float(f2bf(win[(size_t)k * WIN_COLS + 3864 + col]) << 16); g += __uint_as_float((unsigned)U[(size_t)row * DM + k] << 16) * wv; }
            const bf16_t* oc = (const bf16_t*)(ws + WS_OCONV);
            for (int k = 0; k < 512; ++k) { const float wv = __uint_as_float(f2bf(wb[(size_t)k * DM + col]) << 16); v += __uint_as_float((unsigned)oc[(size_t)row * 512 + k] << 16) * wv; }
            const float ref = v / (1.0f + expf(-g)); const float got = __uint_as_float((unsigned)((const bf16_t*)(ws + WS_SGB))[(size_t)row * DM + col] << 16);
            if (DBG_STRAT) { atomicOr((unsigned*)ws, 1u); if (!(fabsf(ref - got) < 0.03f + 0.02f * fabsf(ref))) atomicAdd((unsigned*)ws + 1, 1u); }
        }
#endif
#if DBG_GATE == 3
        if (ph == PH_GA && bid < 4) {
            const int sidx = bid * 512 + tid; const int row = (int)(((long long)sidx * 7919) % T), col = (int)(((long long)sidx * 104729) % 1024);
            float ss = 0.f; for (int k = 0; k < DM; ++k) { const float hv = H[(size_t)row * DM + k]; ss += hv * hv; }
            const float ref = H[(size_t)row * DM + col] * (1.0f / sqrtf(ss * (1.f / DM) + EPSN)) * ((const float*)a.in[7])[col];
            const float got = __uint_as_float((unsigned)U[(size_t)row * DM + col] << 16);
            if (!(fabsf(ref - got) < 0.02f + 0.01f * fabsf(ref))) { atomicOr((unsigned*)ws, 1u); atomicAdd((unsigned*)ws + 1, 1u); }
        }
#endif
        if ((DBG_GATE == 1 || DBG_GATE == 4) && ph == PH_PB) J.kind = -2;
        if ((DBG_GATE == 1 || DBG_GATE == 4) && ph == PH_PB && bid < 4) {
            const int sidx = bid * 512 + tid; const int row = (int)(((long long)sidx * 7919) % T), col = (int)(((long long)sidx * 104729) % 1024);
            const float* win = (const float*)a.in[8]; float g = 0.f;
            for (int k = 0; k < DM; ++k) { const float wv = __uint_as_float(f2bf(win[(size_t)k * WIN_COLS + 3864 + col]) << 16); g += __uint_as_float((unsigned)U[(size_t)row * DM + k] << 16) * wv; }
            const float ref = 1.0f / (1.0f + expf(-g)); const float got = __uint_as_float((unsigned)((const bf16_t*)(ws + WS_SGB))[(size_t)row * DM + col] << 16);
#if DBG_GATE == 4
            if (fabsf(g) > 3.0f) { atomicOr((unsigned*)ws, 1u); atomicAdd((unsigned*)ws + 1, 1u); }
#else
            if (DBG_STRAT) { atomicOr((unsigned*)ws, 1u); if (!(fabsf(ref - got) < 0.03f)) atomicAdd((unsigned*)ws + 1, 1u); }
#endif
            { const bf16_t* wt = (const bf16_t*)(ws + WS_WGB); bool bad = false;
              for (int k = 0; k < DM; k += 37) { if (wt[(size_t)col * DM + k] != (bf16_t)f2bf(win[(size_t)k * WIN_COLS + 3864 + col])) bad = true; }
              if (bad) atomicOr((unsigned*)ws, 2u); }
        }
        if (ph == PH_FNORM) { if (*(volatile unsigned*)ws != 0u) { for (int row = gw; row < T; row += NGW) for (int j = 0; j < 4; ++j) { const float fv = (*(volatile unsigned*)ws & 2u) ? 100.f : 1.0f + 9.0f * (float)((volatile unsigned*)ws)[1] / 2048.0f; ((f32x4*)(a.out + (size_t)row * DM))[lane + 64 * j] = (f32x4){fv, fv, fv, fv}; } continue; } }
#endif
#ifdef SKIP_PH
        if (((SKIP_PH) >> ph) & 1) J.kind = -2;
#endif
        if (J.kind >= 0) {
            EpiSwitch E; E.J = J;
            E.W.ws = ws; E.W.sg = nullptr;
            pg8::Gemm g{J.A, J.Bt, J.M, J.N, J.K, J.lda}; pg8::StaticOrder S; S.init(J.M, J.N, G, (bid + J.rot) % G);
#ifndef NO_GEMM
            pg8::gemm_phase<EpiSwitch, pg8::StaticOrder, GP_ALIGN, GP_SP2>(lds, g, S, E);
#endif
#ifdef REP_PH
            if (ph == REP_PH) pg8::gemm_phase<EpiSwitch, pg8::StaticOrder, GP_ALIGN, GP_SP2>(lds, g, S, E);
#endif
        } else if (ph == PH_PRO) {
            LAS float* scr = (LAS float*)(lds + wave * 17024);
            int base = 0;
#pragma unroll
            for (int jb = 0; jb < 17; ++jb) {
                const float* W0 = nullptr; const float* W1 = nullptr; const float* gn = nullptr; int K = 0, N = 0, P = 0, pk = PK_ID; size_t dst = 0;
                switch (jb) {
                case 0: W0 = (const float*)a.in[4]; W1 = (const float*)a.in[5]; K = DM; N = FF; P = 2 * FF; pk = PK_SWIGLU; dst = WS_F1UP; break;
                case 1: W0 = (const float*)a.in[6]; K = FF; N = DM; P = DM; dst = WS_F1DN; break;
                case 2: gn = (const float*)a.in[22]; W0 = (const float*)a.in[23]; W1 = (const float*)a.in[24]; K = DM; N = FF; P = 2 * FF; pk = PK_SWIGLU; dst = WS_F2UP; break;
                case 3: W0 = (const float*)a.in[25]; K = FF; N = DM; P = DM; dst = WS_F2DN; break;
                case 4: gn = (const float*)a.in[7]; W0 = (const float*)a.in[8]; K = DM; N = WIN_COLS; P = 2816; pk = PK_WIN; dst = WS_WIN; break;
                case 15: gn = (const float*)a.in[7]; W0 = (const float*)a.in[8]; K = DM; N = WIN_COLS; P = DM; pk = PK_GA; dst = WS_WGA; break;
                case 16: gn = (const float*)a.in[7]; W0 = (const float*)a.in[8]; K = DM; N = WIN_COLS; P = DM; pk = PK_GB; dst = WS_WGB; break;
                case 5: gn = (const float*)a.in[7]; W0 = (const float*)a.in[8]; K = DM; N = WIN_COLS; P = 256; pk = PK_VT; dst = WS_WVT; break;
                case 6: W0 = (const float*)a.in[10]; K = 2048; N = 256; P = 256; dst = WS_CK1; break;
                case 7: W0 = (const float*)a.in[14]; K = 2048; N = 256; P = 256; dst = WS_CV1; break;
                case 8: W0 = (const float*)a.in[12]; K = 256; N = 64; P = 256; pk = PK_PAD64; dst = WS_CK2; break;
                case 9: W0 = (const float*)a.in[16]; K = 256; N = 64; P = 256; pk = PK_PAD64; dst = WS_CV2; break;
                case 10: W0 = (const float*)a.in[19]; K = 512; N = DM; P = DM; dst = WS_PA; break;
                case 11: W0 = (const float*)a.in[20]; K = 512; N = DM; P = DM; dst = WS_PB; break;
                case 12: W0 = (const float*)a.in[21]; K = DM; N = DM; P = DM; dst = WS_WO; break;
                case 13: gn = (const float*)a.in[26]; W0 = (const float*)a.in[27]; K = DM; N = DM; P = DM; dst = WS_PG; break;
                case 14: W0 = (const float*)a.in[28]; K = 256; N = DM; P = DM; dst = WS_PP; break;
                }
                const int nblk = P / 64, nitems = (K / 64) * nblk;
                int first = (gw - base) % NGW; if (first < 0) first += NGW;
                if (!(PRO_SKIP_T && it_ < 0)) for (int it = first; it < nitems; it += NGW) transpose_item(W0, W1, gn, K, N, pk, (bf16_t*)(ws + dst), scr, it, nblk, lane);
                base += nitems;
            }
            for (int ib = bid * 512; ib < 3 * T; ib += G * 512) ((float*)(ws + WS_SUMSQ))[ib + tid] = 0.f;
            for (int ibs = bid * 512; ibs < T * 32; ibs += 4 * G * 512) { const int ib = ibs + tid;
                int pr[4];
#pragma unroll
                for (int k = 0; k < 4; ++k) { const int idx = ib + k * G * 512; pr[k] = idx < T * 32 ? positions[idx >> 5] : 0; }
#pragma unroll
                for (int k = 0; k < 4; ++k) { const int idx = ib + k * G * 512;
                    if (idx < T * 32) {
                        const double ang = (double)pr[k] * a.invf[idx & 31];
                        const double kk = rint(ang * 0.15915494309189535);
                        double r = fma(-kk, 6.283185307179586, ang); r = fma(-kk, 2.4492935982947064e-16, r);
                        const float rf = (float)r;
                        float2 cs; cs.x = cosf(rf); cs.y = sinf(rf);
                        ((float2*)(ws + WS_ROPE))[idx] = cs; }
                    asm volatile("" ::: "memory"); }
            }
            for (int ob = bid; ob < 256; ob += G) {
                const int mat = ob >> 7, n0 = (ob & 127) * 2;
                const float* posk = (const float*)a.in[9]; const float* posv = (const float*)a.in[13]; const float* w1k = (const float*)a.in[10]; const float* w1v = (const float*)a.in[14]; const float* b1k = (const float*)a.in[11]; const float* b1v = (const float*)a.in[15];
                const float* pos = mat ? posv : posk; const float* w1 = mat ? w1v : w1k; const float* b1 = mat ? b1v : b1k;
                float s0 = 0.f, s1 = 0.f;
#pragma unroll
                for (int i = 0; i < 4; ++i) { const int kk = tid * 4 + i; const float pv = pos[kk]; const float2 wv = *(const float2*)(w1 + (size_t)kk * 256 + n0); s0 += pv * wv.x; s1 += pv * wv.y; }
                s0 = wave_sum(s0); s1 = wave_sum(s1);
                LAS float* red = (LAS float*)(lds + 137216);
                __syncthreads();
                if (lane == 0) { red[wave * 2] = s0; red[wave * 2 + 1] = s1; }
                __syncthreads();
                if (tid < 2) { float tsum = b1[n0 + tid]; for (int q = 0; q < 8; ++q) tsum += red[q * 2 + tid]; ((float*)(ws + (mat ? WS_BIASV : WS_BIASK)))[n0 + tid] = tsum; }
            }
            for (int row = gw; row < T; row += 4 * NGW) norm_rows_n<false, 4>(x, (const float*)a.in[3], U, row, NGW, lane);
        } else if ((ph == PH_PCONV || ph == PH_CONV) && G == 256 && (bid < 16 || bid >= 240)) {
        } else if (ph == PH_PCONV) {
            bf16_t* pb = (bf16_t*)(ws + WS_PBF);
            const int eb = (G == 256) ? bid - 16 : bid, EG = (G == 256) ? 224 : G;
            for (size_t i8 = (size_t)eb * 512 + tid; i8 < (size_t)T * 256 / 8; i8 += (size_t)EG * 512) { const f32x4 v0 = ((const f32x4*)pin)[2 * i8], v1 = ((const f32x4*)pin)[2 * i8 + 1]; ((u32x4*)pb)[i8] = pack8(v0, v1); }
        } else if (ph == PH_FNORM) {
            for (int row = gw; row < T; row += 4 * NGW) norm_rows_n<true, 4>(H, (const float*)a.in[29], a.out, row, NGW, lane);
        } else if (ph == PH_CONV) {
            const bf16_t* cb = (const bf16_t*)(ws + WS_CB); const bf16_t* cc = cb + (size_t)T * 512; const bf16_t* cx = cc + (size_t)T * 512; bf16_t* oc = (bf16_t*)(ws + WS_OCONV);
            const float* cw = (const float*)a.in[17]; const float* cbias = (const float*)a.in[18];
            const int eb = (G == 256) ? bid - 16 : bid, EG = (G == 256) ? 224 : G;
            for (int it = eb * 512 + tid; it < (T / 16) * 64; it += EG * 512) {
                const int c0 = (it & 63) * 8, tc0 = (it >> 6) * 16;
                f32x4 w0a = *(const f32x4*)(cw + c0), w0b = *(const f32x4*)(cw + c0 + 4), w1a = *(const f32x4*)(cw + 512 + c0), w1b = *(const f32x4*)(cw + 512 + c0 + 4);
                f32x4 w2a = *(const f32x4*)(cw + 1024 + c0), w2b = *(const f32x4*)(cw + 1024 + c0 + 4), bia = *(const f32x4*)(cbias + c0), bib = *(const f32x4*)(cbias + c0 + 4);
                f32x4 u2a = {0.f, 0.f, 0.f, 0.f}, u2b = u2a, u1a = u2a, u1b = u2a;
                if ((tc0 & (SEQ - 1)) != 0) {
                    f32x4 ca, cbb, xa, xb;
                    unpack8(*(const u32x4*)(cc + (size_t)(tc0 - 2) * 512 + c0), ca, cbb); unpack8(*(const u32x4*)(cx + (size_t)(tc0 - 2) * 512 + c0), xa, xb); u2a = ca * xa; u2b = cbb * xb;
                    unpack8(*(const u32x4*)(cc + (size_t)(tc0 - 1) * 512 + c0), ca, cbb); unpack8(*(const u32x4*)(cx + (size_t)(tc0 - 1) * 512 + c0), xa, xb); u1a = ca * xa; u1b = cbb * xb;
                }
                u32x4 ncc = *(const u32x4*)(cc + (size_t)tc0 * 512 + c0), ncx = *(const u32x4*)(cx + (size_t)tc0 * 512 + c0), ncb = *(const u32x4*)(cb + (size_t)tc0 * 512 + c0);
#pragma unroll 4
                for (int tt = 0; tt < 16; ++tt) {
                    const size_t o = (size_t)(tc0 + tt) * 512 + c0;
                    const u32x4 wcc = ncc, wcx = ncx, wcb = ncb;
                    if (tt < 15) { ncc = *(const u32x4*)(cc + o + 512); ncx = *(const u32x4*)(cx + o + 512); ncb = *(const u32x4*)(cb + o + 512); }
                    f32x4 ca, cbb, xa, xb, ba, bb;
                    unpack8(wcc, ca, cbb); unpack8(wcx, xa, xb); unpack8(wcb, ba, bb);
                    const f32x4 u0a = ca * xa, u0b = cbb * xb;
                    const f32x4 ya = w0a * u2a + w1a * u1a + w2a * u0a + bia, yb = w0b * u2b + w1b * u1b + w2b * u0b + bib;
                    *(u32x4*)(oc + o) = pack8(ba * ya, bb * yb);
                    u2a = u1a; u2b = u1b; u1a = u0a; u1b = u0b;
                }
            }
        } else if (ph == PH_ATTN) {
            AttnP P; P.q = (const bf16_t*)(ws + WS_Q); P.kcomp = (const bf16_t*)(ws + WS_KCOMP); P.vcompT = (const bf16_t*)(ws + WS_VCOMPT); P.ks = (const bf16_t*)(ws + WS_KS); P.kw = (const bf16_t*)(ws + WS_KW);
            P.VT = (const bf16_t*)(ws + WS_VT); P.gates = (const float*)(ws + WS_GATES); P.scratch = (float*)(ws + WS_CB); P.scratch2 = nullptr; P.onsa = (bf16_t*)(ws + WS_ONSA);
#ifdef ZERO_ATTN
            for (size_t i8 = (size_t)bid * 512 + tid; i8 < (size_t)T * 512 / 8; i8 += (size_t)G * 512) ((u32x4*)P.onsa)[i8] = (u32x4){0u, 0u, 0u, 0u};
#endif
#if !defined(NO_ATTN) && !defined(ZERO_ATTN)
            {
                unsigned* qctr = (unsigned*)ws + 6144; const int bgi = bid & 7;
                LAS unsigned* nxt = (LAS unsigned*)(lds + 140000);
                for (;;) {
                    if (tid == 0) nxt[0] = atomicAdd(qctr + 64 * bgi, 1u);
                    __syncthreads();
                    const unsigned un = nxt[0];
                    __syncthreads();
                    if (un >= 64u) break;
                    attn_unit(lds, P, bgi >> 1, bgi & 1, 63 - (int)un, tid, wave, lane);
                }
            }
#endif

        }
#if !SPLIT_LAUNCH
        if (ph + 1 < a.ph_hi && sync_after(ph)) { if (a.ph_lo < 0) cg::this_grid().sync();   xcd_barrier(xbar); }
#endif
#ifdef SYNC_PROBE
        if (ph == PH_PRO) for (int i_ = 0; i_ < SYNC_PROBE; ++i_) cg::this_grid().sync();
#endif
    }
}

extern "C" void kernel_launch(void* const* d_in, const int* in_sizes, int n_in, void* d_out, int out_size, void* d_ws, size_t ws_size, hipStream_t stream) {
    static int grid = 0;
    if (grid == 0) {
        if (n_in != 30 || out_size != T * DM || ws_size < WS_END) { fprintf(stderr, "kernel_launch: unexpected problem (n_in %d out %d ws %zu)\n", n_in, out_size, ws_size); grid = -1; return; }
        {
            const long long exp_sz[30] = {(long long)T * DM, (long long)T * 256, T, DM, (long long)DM * FF, (long long)DM * FF, (long long)FF * DM, DM, (long long)DM * WIN_COLS, 2048, 2048 * 256, 256, 256 * 64,
                                          2048, 2048 * 256, 256, 256 * 64, 3 * 512, 512, 512 * DM, 512 * DM, (long long)DM * DM, DM, (long long)DM * FF, (long long)DM * FF, (long long)FF * DM, DM, (long long)DM * DM, 256 * DM, DM};
            for (int i = 0; i < 30; ++i) if ((long long)in_sizes[i] != exp_sz[i]) { fprintf(stderr, "kernel_launch: input %d has %d elements, expected %lld\n", i, in_sizes[i], exp_sz[i]); grid = -1; return; }
        }
        int dev = 0, cus = 0, per_cu = 0;
        hipGetDevice(&dev); hipDeviceGetAttribute(&cus, hipDeviceAttributeMultiprocessorCount, dev);
        if (hipFuncSetAttribute((const void*)fwd_kernel, hipFuncAttributeMaxDynamicSharedMemorySize, LDS_BYTES) != hipSuccess) { fprintf(stderr, "kernel_launch: hipFuncSetAttribute failed\n"); grid = -1; return; }
        if (hipOccupancyMaxActiveBlocksPerMultiprocessor(&per_cu, (const void*)fwd_kernel, 512, LDS_BYTES) != hipSuccess || per_cu < 1) { fprintf(stderr, "kernel_launch: occupancy query says %d\n", per_cu); per_cu = 1; }
        (void)hipGetLastError();
        grid = cus * per_cu;
    }
    if (grid < 0) return;
    Args a{};
    for (int i = 0; i < 30; ++i) a.in[i] = d_in[i];
    a.out = (float*)d_out; a.ws = (unsigned char*)d_ws;
    for (int f = 0; f < 32; ++f) a.invf[f] = pow(10000.0, -(double)f / 32.0);
#if SPLIT_LAUNCH
    int lo = 0;
    for (int k = 0; k < PH_N; ++k) if (sync_after(k) || k == PH_N - 1) { a.ph_lo = lo; a.ph_hi = k + 1; hipLaunchKernelGGL(fwd_kernel, dim3(grid), dim3(512), LDS_BYTES, stream, a); lo = k + 1; }
#else
    (void)hipMemsetAsync(d_ws, 0, 32768, stream);
    a.ph_lo = 0; a.ph_hi = PH_N;
    void* args[] = {&a};
    hipError_t e = hipLaunchCooperativeKernel((const void*)fwd_kernel, dim3(grid), dim3(512), args, LDS_BYTES, stream);
    if (e != hipSuccess) fprintf(stderr, "cooperative launch failed: %s (grid %d)\n", hipGetErrorString(e), grid);
#endif
}
```

```cpp
#include <hip/hip_runtime.h>
#include <hip/hip_cooperative_groups.h>
#include <cstdio>
#include <cstdint>
#include <cmath>
namespace cg = cooperative_groups;
#ifndef SPLIT_LAUNCH
#define SPLIT_LAUNCH 0
#endif
#ifndef EPI_DRAIN
#define EPI_DRAIN 0
#endif
#ifndef DBG_GATE
#define DBG_GATE 0
#endif
#ifndef DBG_STRAT
#define DBG_STRAT 1
#endif
#ifndef ATTN_REPS
#define ATTN_REPS 1
#endif
#ifndef GP_ALIGN
#define GP_ALIGN true
#endif
#ifndef GP_SP2
#define GP_SP2 true
#endif
namespace pg8 {
#define PG8_LAS __attribute__((address_space(3)))
typedef unsigned short bf16_t;
typedef short bf16x8 __attribute__((ext_vector_type(8)));
typedef float f32x4 __attribute__((ext_vector_type(4)));
typedef unsigned u32x4 __attribute__((ext_vector_type(4)));
constexpr int BM = 256, BK = 64, HALF = 128, HTB = HALF * BK * 2  , STAGE_BYTES = 8 * HTB, NXCD = 8, WGM = 8;

__host__ __device__ __forceinline__ int lds_byte(int r, int c) { const int st = (r >> 4) * 2 + (c >> 5), rr = r & 15, cc = c & 31, ob = rr * 64 + cc * 2; return st * 1024 + (ob ^ (((ob >> 9) & 1) << 5)); }
__host__ __device__ __forceinline__ void stage_rc(int b, int& R, int& C) { const int st = b / 1024, sb = b % 1024, swz = sb ^ (((sb >> 9) & 1) << 5); R = (st >> 1) * 16 + swz / 64; C = (st & 1) * 32 + (swz % 64) / 2; }
__host__ __device__ __forceinline__ int perm32(int rho) { const int n = rho >> 4, i = rho & 15; return 8 * (i >> 2) + 4 * n + (i & 3); }

struct Unit { int pm, pn; };
struct Gemm { const bf16_t* A; const bf16_t* Bt; int M, N, K, lda; };

struct StaticOrder {
    int nM, nN, nwg, G, c;
    __host__ __device__ void init(int M, int N, int G_, int c_) { nM = M / BM; nN = N / BM; nwg = nM * nN; G = G_; c = c_; }
    __host__ __device__ bool next(int i, Unit& u) const {
        const long L = (long)i * G + c; if (L >= nwg) return false;
        int wgid = (int)L; { const int q = nwg / NXCD, r = nwg % NXCD, xcd = wgid % NXCD, off = wgid / NXCD; wgid = (xcd < r ? xcd * (q + 1) : r * (q + 1) + (xcd - r) * q) + off; }
        const int nig = WGM * nN, gid = wgid / nig, fm = gid * WGM, gsz = (nM - fm) < WGM ? (nM - fm) : WGM;
        u.pm = fm + ((wgid % nig) % gsz); u.pn = (wgid % nig) / gsz; return true;
    }
    __device__ __forceinline__ void a_ready(const Unit&) const {}
    __device__ __forceinline__ void done(const Unit&) const {}
};

template <class Epi, class Sched, bool ALIGN_EPI = false, bool SP2 = false>
__device__ __forceinline__ void gemm_phase(PG8_LAS unsigned char* lds, const Gemm g, const Sched& S, const Epi& E) {
    int tid_ = threadIdx.x; asm volatile("" : "+v"(tid_));
    const int tid = tid_, wid = __builtin_amdgcn_readfirstlane(tid >> 6), lane = tid & 63, wr = wid >> 2, wc = wid & 3, fr = lane & 15, fq = lane >> 4;
    const int K = g.K, nt = K / BK;
    unsigned voffA[2], voffB[2];
#pragma unroll
    for (int i = 0; i < 2; ++i) { int R, C; stage_rc(tid * 16 + i * 8192, R, C); const int Rb = Epi::PERM ? ((R & ~31) + perm32(R & 31)) : R;
        voffA[i] = (unsigned)(R * g.lda + C) * 2u; voffB[i] = (unsigned)(Rb * K + C) * 2u; }
    const size_t kstep = (size_t)(BK * 2);
    const size_t hstepA = (size_t)HALF * g.lda * 2, hstepB = (size_t)HALF * K * 2;
    const size_t tstepA = 2 * hstepA, tstepB = 2 * hstepB;
    const unsigned ldsw = (unsigned)wid * 1024u;
    const int aoff = lds_byte(wr * 64 + fr, fq * 8), boff = lds_byte(wc * 32 + fr, fq * 8);
#define PG8_SA(b, h) (((b) * 2 + (h)) * HTB)
#define PG8_SB(b, h) ((4 + (b) * 2 + (h)) * HTB)
#define PG8_STAGE(bufoff, gbase, voff) do { _Pragma("unroll") for (int _i = 0; _i < 2; ++_i) \
        __builtin_amdgcn_global_load_lds((const unsigned*)((const char*)(gbase) + (voff)[_i]), (PG8_LAS unsigned*)(lds + (bufoff) + ldsw + _i * 8192), 16, 0, 0); } while (0)
#define PG8_LDA(dst, b, h) do { _Pragma("unroll") for (int m = 0; m < 4; ++m) _Pragma("unroll") for (int k = 0; k < 2; ++k) dst[m][k] = *(const PG8_LAS bf16x8*)(lds + PG8_SA(b, h) + aoff + m * 2048 + k * 1024); } while (0)
#define PG8_LDB(dst, b, h) do { _Pragma("unroll") for (int n = 0; n < 2; ++n) _Pragma("unroll") for (int k = 0; k < 2; ++k) dst[n][k] = *(const PG8_LAS bf16x8*)(lds + PG8_SB(b, h) + boff + n * 2048 + k * 1024); } while (0)
#define PG8_MMA(ai, bj, At, Bt) do { __builtin_amdgcn_s_setprio(1); _Pragma("unroll") for (int m = 0; m < 4; ++m) _Pragma("unroll") for (int n = 0; n < 2; ++n) _Pragma("unroll") for (int k = 0; k < 2; ++k) \
        acc[ai][bj][m][n] = __builtin_amdgcn_mfma_f32_16x16x32_bf16(Bt[n][k], At[m][k], acc[ai][bj][m][n], 0, 0, 0); __builtin_amdgcn_s_setprio(0); } while (0)
#define PG8_WAIT_V(n) asm volatile("s_waitcnt vmcnt(" #n ")" ::: "memory")
#define PG8_WAIT_L(n) asm volatile("s_waitcnt lgkmcnt(" #n ")" ::: "memory")
#define PG8_BAR __builtin_amdgcn_s_barrier()
#define PG8_SCHED __builtin_amdgcn_sched_barrier(0)
    Unit cur, nxt; int ui = 0;
    if (!S.next(0, cur)) return;
    f32x4 acc[2][2][4][2];
#pragma unroll
    for (int a = 0; a < 2; ++a)
#pragma unroll
        for (int b = 0; b < 2; ++b)
#pragma unroll
            for (int m = 0; m < 4; ++m)
#pragma unroll
                for (int n = 0; n < 2; ++n) acc[a][b][m][n] = (f32x4){0.f, 0.f, 0.f, 0.f};
    bf16x8 At[4][2], B0[2][2], B1[2][2];
    const char* cA = (const char*)g.A + (size_t)cur.pm * tstepA; const char* cB = (const char*)g.Bt + (size_t)cur.pn * tstepB;
    S.a_ready(cur);
    if constexpr (SP2) {
        PG8_STAGE(PG8_SB(0, 0), cB, voffB); PG8_STAGE(PG8_SB(0, 1), cB + hstepB, voffB); PG8_STAGE(PG8_SA(0, 0), cA, voffA); PG8_STAGE(PG8_SA(0, 1), cA + hstepA, voffA);
        if (wr == 1) PG8_BAR;
        PG8_WAIT_V(2); PG8_BAR;
        PG8_STAGE(PG8_SB(1, 0), cB + kstep, voffB); PG8_STAGE(PG8_SA(1, 0), cA + kstep, voffA); PG8_STAGE(PG8_SB(1, 1), cB + hstepB + kstep, voffB);
        PG8_WAIT_V(6); PG8_BAR;
    } else {
        PG8_STAGE(PG8_SB(0, 0), cB, voffB); PG8_STAGE(PG8_SA(0, 0), cA, voffA); PG8_STAGE(PG8_SB(0, 1), cB + hstepB, voffB); PG8_STAGE(PG8_SA(0, 1), cA + hstepA, voffA);
        if (wr == 1) PG8_BAR;
        PG8_WAIT_V(4); PG8_BAR;
        PG8_STAGE(PG8_SB(1, 0), cB + kstep, voffB); PG8_STAGE(PG8_SA(1, 0), cA + kstep, voffA); PG8_STAGE(PG8_SB(1, 1), cB + hstepB + kstep, voffB);
        PG8_WAIT_V(6); PG8_BAR;
    }
    for (;;) {
        const bool has_next = S.next(ui + 1, nxt);
        const char* nA = has_next ? (const char*)g.A + (size_t)nxt.pm * tstepA : cA; const char* nB = has_next ? (const char*)g.Bt + (size_t)nxt.pn * tstepB : cB;
        for (int t = 0; t < nt; t += 2) {
            const bool last = (t == nt - 2);
            const char* a1 = cA + (size_t)(t + 1) * kstep;
            const char* a2 = last ? nA : cA + (size_t)(t + 2) * kstep; const char* b2 = last ? nB : cB + (size_t)(t + 2) * kstep;
            const char* a3 = a2 + kstep; const char* b3 = b2 + kstep;
            if (last && has_next) S.a_ready(nxt);
            if constexpr (SP2) {
            PG8_LDB(B0, 0, 0); PG8_LDB(B1, 0, 1); PG8_SCHED; PG8_LDA(At, 0, 0); PG8_STAGE(PG8_SA(1, 1), a1 + hstepA, voffA);
            PG8_WAIT_V(8); PG8_WAIT_L(0); PG8_BAR; PG8_MMA(0, 0, At, B0); PG8_MMA(0, 1, At, B1); PG8_BAR; PG8_SCHED;
            PG8_LDA(At, 0, 1); PG8_STAGE(PG8_SB(0, 0), b2, voffB); PG8_STAGE(PG8_SB(0, 1), b2 + hstepB, voffB); PG8_STAGE(PG8_SA(0, 0), a2, voffA);
            PG8_WAIT_V(8); PG8_WAIT_L(0); PG8_BAR; PG8_MMA(1, 0, At, B0); PG8_MMA(1, 1, At, B1); PG8_BAR; PG8_SCHED;
            PG8_LDB(B0, 1, 0); PG8_LDB(B1, 1, 1); PG8_SCHED; PG8_LDA(At, 1, 0); PG8_STAGE(PG8_SA(0, 1), a2 + hstepA, voffA);
            PG8_WAIT_V(8); PG8_WAIT_L(0); PG8_BAR; PG8_MMA(0, 0, At, B0); PG8_MMA(0, 1, At, B1); PG8_BAR; PG8_SCHED;
            PG8_LDA(At, 1, 1); PG8_STAGE(PG8_SB(1, 0), b3, voffB); PG8_STAGE(PG8_SB(1, 1), b3 + hstepB, voffB); PG8_STAGE(PG8_SA(1, 0), a3, voffA);
            PG8_WAIT_V(8); PG8_WAIT_L(0); PG8_BAR; PG8_MMA(1, 0, At, B0); PG8_MMA(1, 1, At, B1); PG8_BAR; PG8_SCHED;
            } else {
            PG8_LDB(B0, 0, 0); PG8_SCHED; PG8_LDA(At, 0, 0); PG8_STAGE(PG8_SA(1, 1), a1 + hstepA, voffA);
            PG8_WAIT_L(8); PG8_BAR; PG8_WAIT_L(0); PG8_MMA(0, 0, At, B0); PG8_BAR; PG8_SCHED;
            PG8_LDB(B1, 0, 1); PG8_STAGE(PG8_SB(0, 0), b2, voffB);
            PG8_BAR; PG8_WAIT_L(0); PG8_MMA(0, 1, At, B1); PG8_BAR;
            PG8_LDA(At, 0, 1); PG8_STAGE(PG8_SA(0, 0), a2, voffA);
            PG8_BAR; PG8_WAIT_L(0); PG8_MMA(1, 0, At, B0); PG8_BAR; PG8_SCHED;
            PG8_STAGE(PG8_SB(0, 1), b2 + hstepB, voffB);
            PG8_WAIT_V(6); PG8_BAR; PG8_MMA(1, 1, At, B1); PG8_BAR;
            PG8_LDB(B0, 1, 0); PG8_SCHED; PG8_LDA(At, 1, 0); PG8_STAGE(PG8_SA(0, 1), a2 + hstepA, voffA);
            PG8_WAIT_L(8); PG8_BAR; PG8_WAIT_L(0); PG8_MMA(0, 0, At, B0); PG8_BAR; PG8_SCHED;
            PG8_LDB(B1, 1, 1); PG8_STAGE(PG8_SB(1, 0), b3, voffB);
            PG8_BAR; PG8_WAIT_L(0); PG8_MMA(0, 1, At, B1); PG8_BAR;
            PG8_LDA(At, 1, 1); PG8_STAGE(PG8_SA(1, 0), a3, voffA);
            PG8_BAR; PG8_WAIT_L(0); PG8_MMA(1, 0, At, B0); PG8_BAR; PG8_SCHED;
            PG8_STAGE(PG8_SB(1, 1), b3 + hstepB, voffB);
            PG8_WAIT_V(6); PG8_BAR; PG8_MMA(1, 1, At, B1); PG8_BAR;
            }
        }
        if constexpr (ALIGN_EPI) { if (wr == 0) PG8_BAR; }
        if constexpr (!Epi::AFTER_DRAIN) { E(acc, cur, wr, wc, fr, fq); S.done(cur); }
        if (!has_next) break;
#pragma unroll
        for (int a = 0; a < 2; ++a)
#pragma unroll
            for (int b = 0; b < 2; ++b)
#pragma unroll
                for (int m = 0; m < 4; ++m)
#pragma unroll
                    for (int n = 0; n < 2; ++n) acc[a][b][m][n] = (f32x4){0.f, 0.f, 0.f, 0.f};
        cur = nxt; cA = nA; cB = nB; ++ui;
        if constexpr (ALIGN_EPI) { if (wr == 1) PG8_BAR; }
    }
    PG8_WAIT_V(0);
    if constexpr (!ALIGN_EPI) { if (wr == 0) PG8_BAR; }
    PG8_BAR;
    if constexpr (Epi::AFTER_DRAIN) { E.fused(acc, cur, wr, wc, fr, fq, lds, wid, lane); S.done(cur); }
#undef PG8_SA
#undef PG8_SB
#undef PG8_STAGE
#undef PG8_LDA
#undef PG8_LDB
#undef PG8_MMA
#undef PG8_WAIT_V
#undef PG8_WAIT_L
#undef PG8_BAR
#undef PG8_SCHED
}
}

using pg8::bf16_t; using pg8::bf16x8; using pg8::f32x4; using pg8::u32x4;
typedef unsigned u32x2 __attribute__((ext_vector_type(2)));
#define LAS __attribute__((address_space(3)))

constexpr int NB = 4, SEQ = 8192, T = NB * SEQ, DM = 1024, FF = 2816;
constexpr float LOG2E = 1.4426950408889634f;
constexpr float QSCALE = 0.125f * LOG2E;
constexpr float EPSN = 1e-6f;
constexpr int WIN_COLS = 4888;
constexpr int NWAVES = 8;
constexpr int LDS_BYTES = 147456;

constexpr size_t MiB = 1u << 20;
constexpr size_t WS_F1UP = 1 * MiB, WS_F1DN = 12 * MiB, WS_F2UP = 18 * MiB, WS_F2DN = 29 * MiB, WS_WIN = 35 * MiB, WS_WGA = 41 * MiB, WS_WGB = 43 * MiB, WS_WVT = 45 * MiB;
constexpr size_t WS_CK1 = 46 * MiB, WS_CV1 = 47 * MiB, WS_CK2 = 48 * MiB, WS_CV2 = 48 * MiB + 256 * 1024, WS_PA = 49 * MiB, WS_PB = 50 * MiB;
constexpr size_t WS_WO = 51 * MiB, WS_PG = 53 * MiB, WS_PP = 55 * MiB, WS_BIASK = 512 * 1024, WS_BIASV = 512 * 1024 + 4096, WS_ROPE = 57 * MiB;
constexpr size_t WS_U = 72 * MiB;
constexpr size_t WS_H = 136 * MiB;
constexpr size_t WS_BIG = 264 * MiB;
constexpr size_t WS_Q = WS_BIG, WS_CB = WS_BIG + 32 * MiB, WS_KCR = WS_BIG + 128 * MiB, WS_VCR = WS_BIG + 136 * MiB, WS_KS = WS_BIG + 144 * MiB, WS_KW = WS_BIG + 152 * MiB, WS_VT = WS_BIG + 160 * MiB;
constexpr size_t WS_TMP = WS_BIG, WS_PBF = 56 * MiB;
constexpr size_t WS_SUMSQ = 65536;
constexpr size_t WS_SGA = WS_BIG, WS_SGB = WS_BIG + 64 * MiB;
constexpr size_t WS_TAIL = 440 * MiB;
constexpr size_t WS_GATES = WS_TAIL, WS_HCK = WS_TAIL + 3 * MiB, WS_HCV = WS_TAIL + 5 * MiB, WS_KCOMP = WS_TAIL + 7 * MiB, WS_VCOMPT = WS_TAIL + 7 * MiB + 512 * 1024;
constexpr size_t WS_ONSA = WS_TAIL + 8 * MiB, WS_OCONV = WS_TAIL + 40 * MiB, WS_END = 512 * MiB;

__device__ __forceinline__ unsigned cvt_pk_bf16(float lo, float hi) { unsigned r; asm volatile("s_nop 1\n\tv_cvt_pk_bf16_f32 %0, %1, %2" : "=v"(r) : "v"(lo), "v"(hi)); return r; }
__device__ __forceinline__ unsigned cvt_pk_bf16_t(float lo, float hi) { unsigned r; asm volatile("s_nop 1\n\tv_cvt_pk_bf16_f32 %0, %1, %2\n\ts_nop 1" : "=v"(r) : "v"(lo), "v"(hi)); return r; }
__device__ __forceinline__ u32x2 pack4_t(f32x4 a) { u32x2 w; w.x = cvt_pk_bf16_t(a[0], a[1]); w.y = cvt_pk_bf16_t(a[2], a[3]); return w; }
__device__ __forceinline__ u32x4 pack8(f32x4 a, f32x4 b) { u32x4 w; w.x = cvt_pk_bf16(a[0], a[1]); w.y = cvt_pk_bf16(a[2], a[3]); w.z = cvt_pk_bf16(b[0], b[1]); w.w = cvt_pk_bf16(b[2], b[3]); return w; }
__device__ __forceinline__ u32x2 pack4(f32x4 a) { u32x2 w; w.x = cvt_pk_bf16(a[0], a[1]); w.y = cvt_pk_bf16(a[2], a[3]); return w; }
__device__ __forceinline__ float bf_lo(unsigned w) { return __uint_as_float(w << 16); }
__device__ __forceinline__ float bf_hi(unsigned w) { return __uint_as_float(w & 0xffff0000u); }
__device__ __forceinline__ void unpack8(u32x4 w, f32x4& a, f32x4& b) { a[0] = bf_lo(w.x); a[1] = bf_hi(w.x); a[2] = bf_lo(w.y); a[3] = bf_hi(w.y); b[0] = bf_lo(w.z); b[1] = bf_hi(w.z); b[2] = bf_lo(w.w); b[3] = bf_hi(w.w); }
__device__ __forceinline__ float fsigmoid(float x) { return __builtin_amdgcn_rcpf(1.0f + __builtin_amdgcn_exp2f(-x * LOG2E)); }
__device__ __forceinline__ f32x4 sig4(f32x4 v) { f32x4 r; r[0] = fsigmoid(v[0]); r[1] = fsigmoid(v[1]); r[2] = fsigmoid(v[2]); r[3] = fsigmoid(v[3]); return r; }
__device__ __forceinline__ float gelu_tanh(float x) { const float z = 1.5957691216057308f * (x + 0.044715f * x * x * x); return x * fsigmoid(z); }

enum { K_SWIGLU = 0, K_RESID, K_WIN, K_VT, K_GELU, K_KC, K_VCT, K_PROJA, K_PROJB, K_ST32, K_SIG, K_PLE };
struct Job { const bf16_t* A; const bf16_t* Bt; int M, N, K, lda, kind, rot; void* p0; void* p1; void* p2; float scale; const float* rowss; float* ssout; };
struct WinPtrs { unsigned char* ws; bf16_t* sg; };

struct EpiSwitch {
    static constexpr bool PERM = true, AFTER_DRAIN = false;
    Job J; WinPtrs W;
    template <class F> __device__ __forceinline__ void loop(const f32x4 (&acc)[2][2][4][2], const pg8::Unit& u, int wr, int wc, int fr, int fq, const F& f) const {
        const int row0 = u.pm * 256 + wr * 64 + fr, col0 = u.pn * 256 + wc * 32 + 8 * fq;
#pragma unroll
        for (int ai = 0; ai < 2; ++ai)
#pragma unroll
            for (int m = 0; m < 4; ++m)
#pragma unroll
                for (int bj = 0; bj < 2; ++bj) f(row0 + ai * 128 + m * 16, col0 + bj * 128, acc[ai][bj][m][0], acc[ai][bj][m][1]);
    }
    template <class F> __device__ __forceinline__ void loop_rs(const f32x4 (&acc)[2][2][4][2], const pg8::Unit& u, int wr, int wc, int fr, int fq, const float* rowss, const F& f) const {
        const int row0 = u.pm * 256 + wr * 64 + fr, col0 = u.pn * 256 + wc * 32 + 8 * fq;
#pragma unroll
        for (int ai = 0; ai < 2; ++ai)
#pragma unroll
            for (int m = 0; m < 4; ++m) { const int row = row0 + ai * 128 + m * 16; const float rs = __builtin_amdgcn_rsqf(rowss[row] * (1.f / DM) + EPSN);
#pragma unroll
                for (int bj = 0; bj < 2; ++bj) f(row, col0 + bj * 128, acc[ai][bj][m][0] * rs, acc[ai][bj][m][1] * rs); }
    }
    __device__ __forceinline__ void operator()(const f32x4 (&acc)[2][2][4][2], const pg8::Unit& u, int wr, int wc, int fr, int fq) const {
        asm volatile("s_nop 7\n\ts_nop 7\n\ts_nop 7" ::: "memory");
#ifndef EPI_MASK
#define EPI_MASK 0xffff
#endif
#define EPI_ON(k) ((EPI_MASK >> (k)) & 1)
        switch (J.kind) {
        case K_SWIGLU: if (EPI_ON(K_SWIGLU)) { bf16_t* hid = (bf16_t*)J.p0; const float* rowss = J.rowss;
            const int row0 = u.pm * 256 + wr * 64 + fr, hcol = u.pn * 128 + wc * 16 + 4 * (fq & ~1) + 64 * (fq & 1);
#pragma unroll
            for (int ai = 0; ai < 2; ++ai)
#pragma unroll
                for (int m = 0; m < 4; ++m) { const int row = row0 + ai * 128 + m * 16; const float rs = rowss ? __builtin_amdgcn_rsqf(rowss[row] * (1.f / DM) + EPSN) : 1.0f;
                    u32x2 pk[2];
#pragma unroll
                    for (int bj = 0; bj < 2; ++bj) { f32x4 h;
#pragma unroll
                        for (int i = 0; i < 4; ++i) { const float g = acc[ai][bj][m][0][i] * rs, up = acc[ai][bj][m][1][i] * rs; h[i] = g * fsigmoid(g) * up; }
                        pk[bj] = pack4_t(h); }
                    const u32x2 sx = __builtin_amdgcn_permlane16_swap(pk[0].x, pk[1].x, false, false), sy = __builtin_amdgcn_permlane16_swap(pk[0].y, pk[1].y, false, false);
                    const u32x4 o = {sx.x, sy.x, sx.y, sy.y};
                    *(u32x4*)(hid + (size_t)row * FF + hcol) = o; } } break;
        case K_RESID: if (EPI_ON(K_RESID)) { const float* base = (const float*)J.p0; float* out = (float*)J.p1; bf16_t* hb = (bf16_t*)J.p2; float* ssout = J.ssout; const float sc = J.scale;
            const int row0 = u.pm * 256 + wr * 64 + fr, col0 = u.pn * 256 + wc * 32 + 8 * fq;
#pragma unroll
            for (int ai = 0; ai < 2; ++ai)
#pragma unroll
                for (int m = 0; m < 4; ++m) { const int row = row0 + ai * 128 + m * 16; float ss = 0.f;
#pragma unroll
                    for (int bj = 0; bj < 2; ++bj) { const size_t o = (size_t)row * DM + col0 + bj * 128;
                        const f32x4 h0 = *(const f32x4*)(base + o) + acc[ai][bj][m][0] * sc, h1 = *(const f32x4*)(base + o + 4) + acc[ai][bj][m][1] * sc;
                        *(f32x4*)(out + o) = h0; *(f32x4*)(out + o + 4) = h1; *(u32x4*)(hb + o) = pack8(h0, h1);
                        ss += (h0[0] * h0[0] + h0[1] * h0[1]) + (h0[2] * h0[2] + h0[3] * h0[3]) + (h1[0] * h1[0] + h1[1] * h1[1]) + (h1[2] * h1[2] + h1[3] * h1[3]); }
                    ss += __shfl_xor(ss, 16); ss += __shfl_xor(ss, 32);
                    if (fq == 0) atomicAdd(ssout + row, ss); } } break;
        case K_WIN: if (EPI_ON(K_WIN)) {
            unsigned char* const wsb = W.ws;
            bf16_t* const Wq = (bf16_t*)(wsb + WS_Q); bf16_t* const Wvcr = (bf16_t*)(wsb + WS_VCR); bf16_t* const Wcb = (bf16_t*)(wsb + WS_CB); float* const Wgates = (float*)(wsb + WS_GATES); const float* const Wrope = (const float*)(wsb + WS_ROPE);
            loop_rs(acc, u, wr, wc, fr, fq, J.rowss, [=](int row, int col, f32x4 v0, f32x4 v1) {
                const int b = row >> 13, t = row & 8191;
                if (col < 1024) {
                    if (col >= 640 && col < 768) { const int cc = col - 640, g = cc >> 6, d0 = cc & 63;
                        *(u32x4*)(Wvcr + ((size_t)((b * 2 + g) * SEQ + t)) * 64 + d0) = pack8(v0, v1);
                    } else {
                        const int q8 = (col & 63) >> 3;
                        const f32x4 r0 = *(const f32x4*)(Wrope + (size_t)row * 64 + 8 * q8), r1 = *(const f32x4*)(Wrope + (size_t)row * 64 + 8 * q8 + 4);
                        const float c[4] = {r0[0], r0[2], r1[0], r1[2]}, s[4] = {r0[1], r0[3], r1[1], r1[3]};
                        float sc = 1.f; bf16_t* dst;
                        if (col < 512) { dst = Wq + (size_t)row * 512 + (col & ~63) + 4 * q8; sc = QSCALE; }
                        else { const size_t boff = col < 640 ? WS_KCR : (col < 896 ? WS_KS : WS_KW); bf16_t* bp = (bf16_t*)(wsb + boff); const int g = (col >> 6) & 1; dst = bp + ((size_t)((b * 2 + g) * SEQ + t)) * 64 + 4 * q8; }
                        f32x4 o1, o2;
#pragma unroll
                        for (int i = 0; i < 4; ++i) { o1[i] = (v0[i] * c[i] - v1[i] * s[i]) * sc; o2[i] = (v1[i] * c[i] + v0[i] * s[i]) * sc; }
                        *(u32x2*)dst = pack4(o1); *(u32x2*)(dst + 32) = pack4(o2);
                    }
                } else if (col < 2560) { const int cc = col - 1024, which = cc >> 9, c = cc & 511;
                    *(u32x4*)(Wcb + (size_t)which * T * 512 + (size_t)row * 512 + c) = pack8(v0, v1);
                } else { const int cc = col - 2560;
                    if (cc < 24) { float* gp = Wgates + (size_t)row * 24 + cc; *(f32x4*)gp = sig4(v0); *(f32x4*)(gp + 4) = sig4(v1); }
                } }); } break;
        case K_VT: if (EPI_ON(K_VT)) { bf16_t* vt = (bf16_t*)J.p0;
            const float* css = J.rowss;
            loop(acc, u, wr, wc, fr, fq, [=](int row, int col, f32x4 v0, f32x4 v1) { const f32x4 s0 = *(const f32x4*)(css + col), s1 = *(const f32x4*)(css + col + 4);
#pragma unroll
                for (int i = 0; i < 4; ++i) { v0[i] *= __builtin_amdgcn_rsqf(s0[i] * (1.f / DM) + EPSN); v1[i] *= __builtin_amdgcn_rsqf(s1[i] * (1.f / DM) + EPSN); }
                *(u32x4*)(vt + (size_t)row * T + col) = pack8(v0, v1); }); } break;
        case K_GELU: if (EPI_ON(K_GELU)) { bf16_t* out = (bf16_t*)J.p0; const float* bias = (const float*)J.p1;
            loop(acc, u, wr, wc, fr, fq, [=](int row, int col, f32x4 v0, f32x4 v1) { const f32x4 b0 = *(const f32x4*)(bias + col), b1 = *(const f32x4*)(bias + col + 4); f32x4 a, c;
#pragma unroll
                for (int i = 0; i < 4; ++i) { a[i] = gelu_tanh(v0[i] + b0[i]); c[i] = gelu_tanh(v1[i] + b1[i]); }
                *(u32x4*)(out + (size_t)row * 256 + col) = pack8(a, c); }); } break;
        case K_KC: if (EPI_ON(K_KC)) { bf16_t* kc = (bf16_t*)J.p0;
            loop(acc, u, wr, wc, fr, fq, [=](int row, int col, f32x4 v0, f32x4 v1) { if (col < 64) *(u32x4*)(kc + (size_t)row * 64 + col) = pack8(v0, v1); }); } break;
        case K_VCT: if (EPI_ON(K_VCT)) { bf16_t* vct = (bf16_t*)J.p0;
            loop(acc, u, wr, wc, fr, fq, [=](int row, int col, f32x4 v0, f32x4 v1) { if (row < 64) *(u32x4*)(vct + (size_t)row * 4096 + col) = pack8(v0, v1); }); } break;
        case K_PROJA: if (EPI_ON(K_PROJA)) { bf16_t* sg = (bf16_t*)J.p0;
            loop(acc, u, wr, wc, fr, fq, [=](int row, int col, f32x4 v0, f32x4 v1) { const size_t o = (size_t)row * DM + col; f32x4 s0, s1; unpack8(*(const u32x4*)(sg + o), s0, s1);
                *(u32x4*)(sg + o) = pack8(s0 * v0, s1 * v1); }); } break;
        case K_PROJB: if (EPI_ON(K_PROJB)) { bf16_t* sg = (bf16_t*)J.p0; const bf16_t* tmp = (const bf16_t*)J.p1;
            loop(acc, u, wr, wc, fr, fq, [=](int row, int col, f32x4 v0, f32x4 v1) { const size_t o = (size_t)row * DM + col; f32x4 s0, s1, t0, t1; unpack8(*(const u32x4*)(sg + o), s0, s1); unpack8(*(const u32x4*)(tmp + o), t0, t1);
#ifdef X3_GATE_PLUS_HALF
                s0 = s0 + 0.5f; s1 = s1 + 0.5f;
#endif
                *(u32x4*)(sg + o) = pack8(t0 + s0 * v0, t1 + s1 * v1); }); } break;
        case K_SIG: if (EPI_ON(K_SIG)) { bf16_t* sg = (bf16_t*)J.p0;
            loop_rs(acc, u, wr, wc, fr, fq, J.rowss, [=](int row, int col, f32x4 v0, f32x4 v1) {
#ifdef X4_SIG_CONST
                const f32x4 hf = {0.5f, 0.5f, 0.5f, 0.5f}; *(u32x4*)(sg + (size_t)row * DM + col) = pack8(hf + v0 * 0.f, hf + v1 * 0.f);
#else
#ifdef X6_SCALE
                *(u32x4*)(sg + (size_t)row * DM + col) = pack8(sig4(v0 * X6_SCALE), sig4(v1 * X6_SCALE));
#else
                *(u32x4*)(sg + (size_t)row * DM + col) = pack8(sig4(v0), sig4(v1));
#endif
#endif
                }); } break;
        case K_ST32: if (EPI_ON(K_ST32)) { bf16_t* tmp = (bf16_t*)J.p0;
            loop(acc, u, wr, wc, fr, fq, [=](int row, int col, f32x4 v0, f32x4 v1) { *(u32x4*)(tmp + (size_t)row * DM + col) = pack8(v0, v1); }); } break;
        default: if (EPI_ON(K_PLE)) { float* H = (float*)J.p0; const bf16_t* tmp = (const bf16_t*)J.p1;
            loop_rs(acc, u, wr, wc, fr, fq, J.rowss, [=](int row, int col, f32x4 v0, f32x4 v1) { const size_t o = (size_t)row * DM + col;
                f32x4 t0, t1; unpack8(*(const u32x4*)(tmp + o), t0, t1); const f32x4 h0 = *(const f32x4*)(H + o), h1 = *(const f32x4*)(H + o + 4);
                *(f32x4*)(H + o) = h0 + sig4(v0) * t0; *(f32x4*)(H + o + 4) = h1 + sig4(v1) * t1; }); } break;
        }
#if EPI_DRAIN
        asm volatile("s_waitcnt vmcnt(0)" ::: "memory");
#endif
    }
};

__device__ __forceinline__ float wave_sum(float v) {
#pragma unroll
    for (int o = 1; o < 64; o <<= 1) v += __shfl_xor(v, o);
    return v;
}
enum { PK_ID = 0, PK_SWIGLU, PK_WIN, PK_VT, PK_PAD64, PK_GA, PK_GB };
__device__ __forceinline__ int rope_perm(int j) { const int head = j >> 6, jj = j & 63, q8 = jj >> 3, w = jj & 7; return head * 64 + (w < 4 ? 4 * q8 + w : 32 + 4 * q8 + (w - 4)); }
__device__ __forceinline__ int src_col(int pk, int p, int& which) {
    which = 0;
    switch (pk) {
    case PK_ID: return p;
    case PK_SWIGLU: { const int grp = p >> 3, w = p & 7; which = (w >= 4); return grp * 4 + (w & 3); }
    case PK_WIN: {
        if (p < 512) return rope_perm(p);
        if (p < 640) return 512 + rope_perm(p - 512);
        if (p < 768) return p;
        if (p < 896) return 768 + rope_perm(p - 768);
        if (p < 1024) return 1024 + rope_perm(p - 896);
        if (p < 2560) return 1304 + (p - 1024);
        return (p - 2560) < 24 ? 1280 + (p - 2560) : -1; }
    case PK_VT: return p < 128 ? 896 + p : 1152 + (p - 128);
    case PK_GA: return 2840 + p;
    case PK_GB: return 3864 + p;
    default: return p < 64 ? p : -1;
    }
}
__device__ __forceinline__ unsigned f2bf(float f) { unsigned u = __builtin_bit_cast(unsigned, f); return (u + 0x7fffu + ((u >> 16) & 1u)) >> 16; }
__device__ __forceinline__ unsigned pk2(float lo, float hi) { return f2bf(lo) | (f2bf(hi) << 16); }
__device__ __forceinline__ void transpose_item(const float* W0, const float* W1, const float* gain, int K, int N, int pk, bf16_t* WT, LAS float* scr, int item, int nblk, int lane) {
    const int kb = item / nblk, nb = item % nblk, k0 = 64 * kb, p0 = 64 * nb;
    const int cg = lane & 15;
    int which; const int sc = src_col(pk, p0 + 4 * cg, which);
    const float* W = which ? W1 : W0;
    f32x4 v[16];
#pragma unroll
    for (int i = 0; i < 16; ++i) { const int kk = 4 * i + (lane >> 4);
        v[i] = sc >= 0 ? *(const f32x4*)(W + (size_t)(k0 + kk) * N + sc) * (gain ? gain[k0 + kk] : 1.0f) : (f32x4){0.f, 0.f, 0.f, 0.f}; }
#pragma unroll
    for (int i = 0; i < 16; ++i) { const int kk = 4 * i + (lane >> 4); LAS float* d = scr + kk * 65 + 4 * cg; d[0] = v[i][0]; d[1] = v[i][1]; d[2] = v[i][2]; d[3] = v[i][3]; }
    asm volatile("s_waitcnt lgkmcnt(0)" ::: "memory");
    const int c = lane & 7;
#pragma unroll
    for (int j = 0; j < 8; ++j) { const int n = (lane >> 3) + 8 * j; const LAS float* s = scr + (8 * c) * 65 + n;
        u32x4 o; o.x = pk2(s[0 * 65], s[1 * 65]); o.y = pk2(s[2 * 65], s[3 * 65]); o.z = pk2(s[4 * 65], s[5 * 65]); o.w = pk2(s[6 * 65], s[7 * 65]);
        *(u32x4*)(WT + (size_t)(p0 + n) * K + k0 + 8 * c) = o; }
    asm volatile("s_waitcnt lgkmcnt(0)" ::: "memory");
}
template <bool OUT32> __device__ __forceinline__ void norm_row(const float* xrow, const float* gain, void* orow, int lane) {
    const f32x4* xr = (const f32x4*)xrow + lane; const f32x4* gr = (const f32x4*)gain + lane;
    f32x4 v[4]; float s = 0.f;
#pragma unroll
    for (int j = 0; j < 4; ++j) { v[j] = xr[64 * j]; s += (v[j].x * v[j].x + v[j].y * v[j].y) + (v[j].z * v[j].z + v[j].w * v[j].w); }
    const float r = 1.0f / sqrtf(wave_sum(s) * (1.f / DM) + EPSN);
#pragma unroll
    for (int j = 0; j < 4; ++j) { const f32x4 o = v[j] * r * gr[64 * j];
        if (OUT32) ((f32x4*)orow)[lane + 64 * j] = o; else ((u32x2*)orow)[lane + 64 * j] = pack4(o); }
}

template <bool OUT32, int NR> __device__ __forceinline__ void norm_rows_n(const float* xbase, const float* gain, void* obase, int row0, int rstride, int lane) {
    f32x4 v[NR][4];
#pragma unroll
    for (int r = 0; r < NR; ++r) { const f32x4* xr = (const f32x4*)(xbase + (size_t)(row0 + r * rstride) * DM) + lane;
#pragma unroll
        for (int j = 0; j < 4; ++j) v[r][j] = xr[64 * j]; }
    const f32x4* gr = (const f32x4*)gain + lane; f32x4 gv[4];
#pragma unroll
    for (int j = 0; j < 4; ++j) gv[j] = gr[64 * j];
#pragma unroll
    for (int r = 0; r < NR; ++r) { float s = 0.f;
#pragma unroll
        for (int j = 0; j < 4; ++j) s += (v[r][j].x * v[r][j].x + v[r][j].y * v[r][j].y) + (v[r][j].z * v[r][j].z + v[r][j].w * v[r][j].w);
        const float rs = 1.0f / sqrtf(wave_sum(s) * (1.f / DM) + EPSN);
#pragma unroll
        for (int j = 0; j < 4; ++j) { const f32x4 o = v[r][j] * rs * gv[j];
            if (OUT32) ((f32x4*)((float*)obase + (size_t)(row0 + r * rstride) * DM))[lane + 64 * j] = o; else ((u32x2*)((bf16_t*)obase + (size_t)(row0 + r * rstride) * DM))[lane + 64 * j] = pack4(o); } }
}

__device__ __forceinline__ float rows_max(float v) {
    u32x2 r = __builtin_amdgcn_permlane16_swap(__float_as_uint(v), __float_as_uint(v), false, false); v = fmaxf(__uint_as_float(r.x), __uint_as_float(r.y));
    r = __builtin_amdgcn_permlane32_swap(__float_as_uint(v), __float_as_uint(v), false, false); return fmaxf(__uint_as_float(r.x), __uint_as_float(r.y));
}
__device__ __forceinline__ unsigned wave_umax(unsigned v) {
    unsigned t;
    t = (unsigned)__builtin_amdgcn_mov_dpp((int)v, 0xB1, 0xF, 0xF, true); v = t > v ? t : v;
    t = (unsigned)__builtin_amdgcn_mov_dpp((int)v, 0x4E, 0xF, 0xF, true); v = t > v ? t : v;
    t = (unsigned)__builtin_amdgcn_mov_dpp((int)v, 0x141, 0xF, 0xF, true); v = t > v ? t : v;
    t = (unsigned)__builtin_amdgcn_mov_dpp((int)v, 0x140, 0xF, 0xF, true); v = t > v ? t : v;
    u32x2 r = __builtin_amdgcn_permlane16_swap(v, v, false, false); v = r.x > r.y ? r.x : r.y;
    r = __builtin_amdgcn_permlane32_swap(v, v, false, false); return r.x > r.y ? r.x : r.y;
}
__device__ __forceinline__ float rows_sum(float v) {
    u32x2 r = __builtin_amdgcn_permlane16_swap(__float_as_uint(v), __float_as_uint(v), false, false); v = __uint_as_float(r.x) + __uint_as_float(r.y);
    r = __builtin_amdgcn_permlane32_swap(__float_as_uint(v), __float_as_uint(v), false, false); return __uint_as_float(r.x) + __uint_as_float(r.y);
}
constexpr int A_KB = 0, A_VB = 18432, A_IMP = 36864, A_SEL = 104448;
struct AttnP { const bf16_t *q, *kcomp, *vcompT, *ks, *kw, *VT; const float* gates; float* scratch; float* scratch2; bf16_t* onsa; };

template <int MODE>
__device__ __forceinline__ void attn_tile(const LAS unsigned char* Ks, const LAS unsigned char* Vs, const bf16x8 (&qf)[4][2], f32x4 (&O)[4][4], float (&m)[4], float (&l)[4], const float (&invl)[4],
                                          int mmode  , bool track, bool lane_valid, int kbase, int kmax, int kmin, LAS float* imp_row, float& carry, int fr, int fq, int lane) {
    const bool masked = (mmode == 2);
#pragma unroll 1
    for (int ks = 0; ks < 2; ++ks) {
        bf16x8 kf[2][2];
#pragma unroll
        for (int sub = 0; sub < 2; ++sub)
#pragma unroll
            for (int ch = 0; ch < 2; ++ch) kf[sub][ch] = *(const LAS bf16x8*)(Ks + (ks * 32 + sub * 16 + fr) * 144 + ch * 64 + fq * 16);
        f32x4 s[4][2];
#pragma unroll
        for (int hh = 0; hh < 4; ++hh)
#pragma unroll
            for (int sub = 0; sub < 2; ++sub) { f32x4 a = {0.f, 0.f, 0.f, 0.f};
                a = __builtin_amdgcn_mfma_f32_16x16x32_bf16(kf[sub][0], qf[hh][0], a, 0, 0, 0);
                a = __builtin_amdgcn_mfma_f32_16x16x32_bf16(kf[sub][1], qf[hh][1], a, 0, 0, 0); s[hh][sub] = a; }
        if (masked) {
#pragma unroll
            for (int sub = 0; sub < 2; ++sub)
#pragma unroll
                for (int i = 0; i < 4; ++i) { const int kidx = kbase + ks * 32 + sub * 16 + 4 * fq + i; const bool v = lane_valid && kidx <= kmax && kidx > kmin;
#pragma unroll
                    for (int hh = 0; hh < 4; ++hh) s[hh][sub][i] = v ? s[hh][sub][i] : -1e30f; }
        }
        bf16x8 pf[4];
        float ps[2][4] = {{0.f, 0.f, 0.f, 0.f}, {0.f, 0.f, 0.f, 0.f}};
#pragma unroll
        for (int hh = 0; hh < 4; ++hh) {
            f32x4 p0, p1;
            if (MODE != 2) {
                float mn = m[hh], alpha = 1.0f;
                if (track) {
                    float mx = fmaxf(fmaxf(fmaxf(s[hh][0][0], s[hh][0][1]), fmaxf(s[hh][0][2], s[hh][0][3])), fmaxf(fmaxf(s[hh][1][0], s[hh][1][1]), fmaxf(s[hh][1][2], s[hh][1][3])));
                    mx = rows_max(mx);
                    if (mmode == 1) mx = lane_valid ? mx : -1e30f;
                    mn = fmaxf(m[hh], mx); alpha = __builtin_amdgcn_exp2f(m[hh] - mn);
                    m[hh] = mn;
                }
#pragma unroll
                for (int i = 0; i < 4; ++i) { p0[i] = __builtin_amdgcn_exp2f(s[hh][0][i] - mn); p1[i] = __builtin_amdgcn_exp2f(s[hh][1][i] - mn); }
                if (masked) {
#pragma unroll
                    for (int i = 0; i < 4; ++i) { p0[i] = s[hh][0][i] < -1e29f ? 0.f : p0[i]; p1[i] = s[hh][1][i] < -1e29f ? 0.f : p1[i]; }
                }
                if (mmode == 1) { const f32x4 z = {0.f, 0.f, 0.f, 0.f}; p0 = lane_valid ? p0 : z; p1 = lane_valid ? p1 : z; }
                l[hh] = l[hh] * alpha + ((p0[0] + p0[1]) + (p0[2] + p0[3])) + ((p1[0] + p1[1]) + (p1[2] + p1[3]));
                if (MODE == 1 && track) { if (__builtin_amdgcn_ballot_w64(alpha != 1.0f) != 0ull) {
#pragma unroll
                    for (int dt = 0; dt < 4; ++dt) O[hh][dt] = O[hh][dt] * alpha; } }
            } else {
                const float mh = m[hh], il = invl[hh];
#pragma unroll
                for (int i = 0; i < 4; ++i) { p0[i] = __builtin_amdgcn_exp2f(s[hh][0][i] - mh) * il; p1[i] = __builtin_amdgcn_exp2f(s[hh][1][i] - mh) * il; }
                if (masked) {
#pragma unroll
                    for (int i = 0; i < 4; ++i) { p0[i] = s[hh][0][i] < -1e29f ? 0.f : p0[i]; p1[i] = s[hh][1][i] < -1e29f ? 0.f : p1[i]; }
                }
#pragma unroll
                for (int i = 0; i < 4; ++i) { ps[0][i] += p0[i]; ps[1][i] += p1[i]; }
            }
            if (MODE != 0) { const u32x4 w = pack8(p0, p1); pf[hh] = __builtin_bit_cast(bf16x8, w); }
        }
        if (MODE == 2) {
            const float a0 = ps[0][0] + ps[0][1] + ps[0][2] + 0.5f * ps[0][3], b0 = 0.5f * ps[0][3];
            const float a1 = ps[1][0] + ps[1][1] + ps[1][2] + 0.5f * ps[1][3], b1 = 0.5f * ps[1][3];
            const int src = (lane - 16) & 63;
            const float x0 = __shfl(b0, src), x1 = __shfl(b1, src);
            const int sa = (kbase + ks * 32) / 4 + fq;
            imp_row[sa] = a0 + (fq > 0 ? x0 : carry);
            imp_row[sa + 4] = a1 + (fq > 0 ? x1 : x0);
            carry = x1;
        }
        if (MODE != 0) {
#pragma unroll
            for (int dt = 0; dt < 4; ++dt) {
                const u32x2 v0 = *(const LAS u32x2*)(Vs + (dt * 16 + fr) * 144 + ks * 64 + fq * 8), v1 = *(const LAS u32x2*)(Vs + (dt * 16 + fr) * 144 + ks * 64 + 32 + fq * 8);
                const u32x4 vv = {v0.x, v0.y, v1.x, v1.y}; const bf16x8 vf = __builtin_bit_cast(bf16x8, vv);
#pragma unroll
                for (int hh = 0; hh < 4; ++hh) O[hh][dt] = __builtin_amdgcn_mfma_f32_16x16x32_bf16(vf, pf[hh], O[hh][dt], 0, 0, 0);
            }
        }
    }
}

template <int BR>
__device__ __forceinline__ void run_branch(LAS unsigned char* lds, const bf16_t* Kg, const bf16_t* Vg, int ldv, int jlo, int jhi, const bf16x8 (&qf)[4][2], f32x4 (&O)[4][4], float (&m)[4], float (&l)[4],
                                           const float (&invl)[4], int tid, int w, int lane, int fr, int fq, int qlo, int tq, int blkq, unsigned long long sel_lo, unsigned long long sel_hi) {
    constexpr int MODE = (BR == 0) ? 0 : (BR == 1 ? 2 : 1);
    const int lrow = tid >> 3, lch = tid & 7;
    u32x4 kr, vr;
#define A_GLOAD(j) do { kr = *(const u32x4*)(Kg + (size_t)(64 * (j) + lrow) * 64 + lch * 8); vr = *(const u32x4*)(Vg + (size_t)lrow * ldv + 64 * (j) + lch * 8); } while (0)
#define A_LSTORE(buf) do { *(LAS u32x4*)(lds + A_KB + (buf) * 9216 + lrow * 144 + lch * 16) = kr; *(LAS u32x4*)(lds + A_VB + (buf) * 9216 + lrow * 144 + lch * 16) = vr; } while (0)
    A_GLOAD(jlo); A_LSTORE(0); __syncthreads();
    float carry = 0.f;
    LAS float* imp_row = (LAS float*)(lds + A_IMP) + (w * 16 + fr) * 132;
    for (int j = jlo; j <= jhi; ++j) {
        const int cur = (j - jlo) & 1;
        if (j < jhi) A_GLOAD(j + 1);
        bool skip = false, masked = false, lane_valid = true; int kmax = 0x7fffffff, kmin = -1;
        if (BR <= 1) { const int lim_lo = (qlo - 31) >> 4, lim_hi = (qlo + 15 - 31) >> 4; kmax = (tq - 31) >> 4; masked = (64 * j + 63 > lim_lo); skip = (BR == 0) && (64 * j > lim_hi); }
        if (BR == 2) { lane_valid = (((j < 64 ? sel_lo : sel_hi) >> (j & 63)) & 1ull) != 0ull; const unsigned long long bal = __builtin_amdgcn_ballot_w64(lane_valid);
            skip = (j > blkq) || (bal == 0ull); masked = (j == blkq) || (bal != ~0ull); kmax = (j == blkq) ? tq : 0x7fffffff; }
        if (BR == 3) { skip = (64 * j > qlo + 15) || (64 * j + 63 <= qlo - 512); masked = (64 * j + 63 > qlo) || (64 * j <= qlo + 15 - 512); kmax = tq; kmin = tq - 512; }
        int mmode = masked ? 2 : 0;
        const bool track = (MODE != 1) || (__builtin_amdgcn_ballot_w64(m[0] < -1e29f) != 0ull);
        if (BR == 2) mmode = (j == blkq) ? 2 : (masked ? 1 : 0);
        if (!skip) attn_tile<MODE>(lds + A_KB + cur * 9216, lds + A_VB + cur * 9216, qf, O, m, l, invl, mmode, track, lane_valid, 64 * j, kmax, kmin, imp_row, carry, fr, fq, lane);
        if (j < jhi) A_LSTORE(cur ^ 1);
        __syncthreads();
    }
#undef A_GLOAD
#undef A_LSTORE
}


__device__ __forceinline__ void run_branch_sel(LAS unsigned char* lds, const bf16_t* Kg, const bf16_t* Vg, int ldv, int jhi, const bf16_t* qbase  ,
                                               const float* gbase  , bf16_t* obase  ,
                                               int tid, int w, int lane, int fr, int fq, int qlo, int blkq) {
    const int lrow = tid >> 3, lch = tid & 7;
    const int ql = fr >> 2, hl = fr & 3;
    bf16x8 qf[4][2]; f32x4 O[4][4]; float m[4], l[4];
#pragma unroll
    for (int gi = 0; gi < 4; ++gi) { m[gi] = -1e30f; l[gi] = 0.f;
#pragma unroll
        for (int ch = 0; ch < 2; ++ch) qf[gi][ch] = *(const bf16x8*)(qbase + (size_t)(gi * 4 + ql) * 512 + hl * 64 + ch * 32 + fq * 8);
#pragma unroll
        for (int dt = 0; dt < 4; ++dt) O[gi][dt] = (f32x4){0.f, 0.f, 0.f, 0.f}; }
    const LAS unsigned* selw = (const LAS unsigned*)(lds + A_SEL) + (w * 16 + ql) * 4;
    u32x4 kr, vr;
#define S_GLOAD(j) do { kr = *(const u32x4*)(Kg + (size_t)(64 * (j) + lrow) * 64 + lch * 8); vr = *(const u32x4*)(Vg + (size_t)lrow * ldv + 64 * (j) + lch * 8); } while (0)
#define S_LSTORE(buf) do { *(LAS u32x4*)(lds + A_KB + (buf) * 9216 + lrow * 144 + lch * 16) = kr; *(LAS u32x4*)(lds + A_VB + (buf) * 9216 + lrow * 144 + lch * 16) = vr; } while (0)
    S_GLOAD(0); S_LSTORE(0); __syncthreads();
    for (int j = 0; j <= jhi; ++j) {
        const int cur = j & 1;
        if (j < jhi) S_GLOAD(j + 1);
        if (j <= blkq) {
            const LAS unsigned char* Ks = lds + A_KB + cur * 9216; const LAS unsigned char* Vs = lds + A_VB + cur * 9216;
            bool lv[4]; unsigned long long bal[4]; bool anyg = false;
#pragma unroll
            for (int gi = 0; gi < 4; ++gi) { lv[gi] = ((selw[gi * 16 + (j >> 5)] >> (j & 31)) & 1u) != 0u; bal[gi] = __builtin_amdgcn_ballot_w64(lv[gi]); anyg = anyg || (bal[gi] != 0ull); }
            if (anyg) {
#pragma unroll
                for (int ks = 0; ks < 2; ++ks) {
                    bf16x8 kf[2][2], vf[4];
#pragma unroll
                    for (int sub = 0; sub < 2; ++sub)
#pragma unroll
                        for (int ch = 0; ch < 2; ++ch) kf[sub][ch] = *(const LAS bf16x8*)(Ks + (ks * 32 + sub * 16 + fr) * 144 + ch * 64 + fq * 16);
#pragma unroll
                    for (int dt = 0; dt < 4; ++dt) { const u32x2 v0 = *(const LAS u32x2*)(Vs + (dt * 16 + fr) * 144 + ks * 64 + fq * 8), v1 = *(const LAS u32x2*)(Vs + (dt * 16 + fr) * 144 + ks * 64 + 32 + fq * 8);
                        const u32x4 vv = {v0.x, v0.y, v1.x, v1.y}; vf[dt] = __builtin_bit_cast(bf16x8, vv); }
#pragma unroll
                    for (int gi = 0; gi < 4; ++gi) {
                        if (bal[gi] != 0ull) {
                            f32x4 s0 = {0.f, 0.f, 0.f, 0.f}, s1 = {0.f, 0.f, 0.f, 0.f};
                            s0 = __builtin_amdgcn_mfma_f32_16x16x32_bf16(kf[0][0], qf[gi][0], s0, 0, 0, 0); s0 = __builtin_amdgcn_mfma_f32_16x16x32_bf16(kf[0][1], qf[gi][1], s0, 0, 0, 0);
                            s1 = __builtin_amdgcn_mfma_f32_16x16x32_bf16(kf[1][0], qf[gi][0], s1, 0, 0, 0); s1 = __builtin_amdgcn_mfma_f32_16x16x32_bf16(kf[1][1], qf[gi][1], s1, 0, 0, 0);
                            const bool alllv = (bal[gi] == ~0ull);
                            if (j == blkq) {
                                const int tqg = qlo + gi * 4 + ql;
#pragma unroll
                                for (int i = 0; i < 4; ++i) { const int k0 = 64 * j + ks * 32 + 4 * fq + i; s0[i] = (k0 <= tqg) ? s0[i] : -1e30f; s1[i] = (k0 + 16 <= tqg) ? s1[i] : -1e30f; }
                            }
                            float mn = m[gi], alpha = 1.0f;
                            const bool track = __builtin_amdgcn_ballot_w64(m[gi] < -1e29f) != 0ull;
                            if (track) {
                                float mx = fmaxf(fmaxf(fmaxf(s0[0], s0[1]), fmaxf(s0[2], s0[3])), fmaxf(fmaxf(s1[0], s1[1]), fmaxf(s1[2], s1[3])));
                                mx = rows_max(mx); mx = lv[gi] ? mx : -1e30f;
                                mn = fmaxf(m[gi], mx); alpha = __builtin_amdgcn_exp2f(m[gi] - mn); m[gi] = mn;
                            }
                            f32x4 p0, p1;
#pragma unroll
                            for (int i = 0; i < 4; ++i) { p0[i] = __builtin_amdgcn_exp2f(s0[i] - mn); p1[i] = __builtin_amdgcn_exp2f(s1[i] - mn); }
                            if (j == blkq) {
#pragma unroll
                                for (int i = 0; i < 4; ++i) { p0[i] = s0[i] < -1e29f ? 0.f : p0[i]; p1[i] = s1[i] < -1e29f ? 0.f : p1[i]; }
                            }
                            if (!alllv) { const f32x4 z = {0.f, 0.f, 0.f, 0.f}; p0 = lv[gi] ? p0 : z; p1 = lv[gi] ? p1 : z; }
                            l[gi] = l[gi] * alpha + ((p0[0] + p0[1]) + (p0[2] + p0[3])) + ((p1[0] + p1[1]) + (p1[2] + p1[3]));
                            if (track) { if (__builtin_amdgcn_ballot_w64(alpha != 1.0f) != 0ull) {
#pragma unroll
                                for (int dt = 0; dt < 4; ++dt) O[gi][dt] = O[gi][dt] * alpha; } }
                            const u32x4 pw = pack8(p0, p1); const bf16x8 pf = __builtin_bit_cast(bf16x8, pw);
#pragma unroll
                            for (int dt = 0; dt < 4; ++dt) O[gi][dt] = __builtin_amdgcn_mfma_f32_16x16x32_bf16(vf[dt], pf, O[gi][dt], 0, 0, 0);
                        }
                    }
                }
            }
        }
        if (j < jhi) S_LSTORE(cur ^ 1);
        __syncthreads();
    }
#undef S_GLOAD
#undef S_LSTORE
#pragma unroll
    for (int gi = 0; gi < 4; ++gi) { const float lt = rows_sum(l[gi]); const float gt = lt > 0.f ? gbase[(size_t)(gi * 4 + ql) * 24 + hl * 3 + 1] / lt : 0.f;
        bf16_t* op = obase + (size_t)(gi * 4 + ql) * 512 + hl * 64 + 4 * fq;
#pragma unroll
        for (int dt = 0; dt < 4; ++dt) *(u32x2*)(op + dt * 16) = pack4(O[gi][dt] * gt); }
}

__device__ __forceinline__ void attn_unit(LAS unsigned char* lds, const AttnP& P, int b, int g, int iu, int tid, int w, int lane) {
    const int fr = lane & 15, fq = lane >> 4;
    const int t0 = iu * 128, qlo = t0 + 16 * w, tq = qlo + fr, blkq = qlo >> 6;
    const size_t rowq = (size_t)b * SEQ + tq;
#define A_STATE() bf16x8 qf[4][2]; f32x4 O[4][4]; float m[4], l[4], invl[4]; \
    _Pragma("unroll") for (int hh = 0; hh < 4; ++hh) _Pragma("unroll") for (int ch = 0; ch < 2; ++ch) qf[hh][ch] = *(const bf16x8*)(P.q + rowq * 512 + (g * 4 + hh) * 64 + ch * 32 + fq * 8)
#define A_RESET() do { _Pragma("unroll") for (int hh = 0; hh < 4; ++hh) { m[hh] = -1e30f; l[hh] = 0.f; invl[hh] = 0.f; _Pragma("unroll") for (int dt = 0; dt < 4; ++dt) O[hh][dt] = (f32x4){0.f, 0.f, 0.f, 0.f}; } } while (0)
#define A_FINL() do { _Pragma("unroll") for (int hh = 0; hh < 4; ++hh) { float lt = rows_sum(l[hh]); invl[hh] = lt > 0.f ? 1.0f / lt : 0.f; } } while (0)
    const int bg = b * 2 + g;
#define A_PTRS() size_t rq_ = rowq; asm volatile("" : "+v"(rq_)); float* scr = P.scratch + rq_ * 512 + g * 256 + 4 * fq; const float* gp = P.gates + rq_ * 24 + g * 12
    { A_STATE();
    {
        const bf16_t* Kc = P.kcomp + (size_t)(bg * 512) * 64; const bf16_t* Vc = P.vcompT + bg * 512;
        const int ntc = (8 * iu + 7 + 63) >> 6;
        A_RESET();
        run_branch<0>(lds, Kc, Vc, 4096, 0, ntc - 1, qf, O, m, l, invl, tid, w, lane, fr, fq, qlo, tq, blkq, 0ull, 0ull);
        A_FINL();
        run_branch<1>(lds, Kc, Vc, 4096, 0, ntc - 1, qf, O, m, l, invl, tid, w, lane, fr, fq, qlo, tq, blkq, 0ull, 0ull);
    }
    {
        LAS float* impw = (LAS float*)(lds + A_IMP) + (w * 16) * 132;
        LAS unsigned* sel = (LAS unsigned*)(lds + A_SEL) + (w * 16) * 4;
        for (int qi = 0; qi < 8; ++qi) {
            unsigned long long loA, hiA = 0ull, loB, hiB = 0ull;
            if (blkq + 1 <= 16) { loA = (2ull << blkq) - 1ull; loB = loA; }
            else {
                loA = 1ull;
                { const int s1 = blkq - 1, s2 = blkq; if (s1 < 64) loA |= 1ull << s1; else hiA |= 1ull << (s1 - 64); if (s2 < 64) loA |= 1ull << s2; else hiA |= 1ull << (s2 - 64); }
                loB = loA; hiB = hiA;
                const float a0 = impw[qi * 132 + lane], a1 = impw[qi * 132 + 64 + lane], b0 = impw[(qi + 8) * 132 + lane], b1 = impw[(qi + 8) * 132 + 64 + lane];
                const bool c0 = (lane >= 1 && lane <= blkq - 2), c1 = (lane + 64 <= blkq - 2);
                unsigned ka0 = c0 ? ((__float_as_uint(a0) & ~127u) | (unsigned)(127 - lane)) : 0u, ka1 = c1 ? ((__float_as_uint(a1) & ~127u) | (unsigned)(63 - lane)) : 0u;
                unsigned kb0 = c0 ? ((__float_as_uint(b0) & ~127u) | (unsigned)(127 - lane)) : 0u, kb1 = c1 ? ((__float_as_uint(b1) & ~127u) | (unsigned)(63 - lane)) : 0u;
                for (int r = 0; r < 13; ++r) {
                    unsigned bestA = ka0 > ka1 ? ka0 : ka1, bestB = kb0 > kb1 ? kb0 : kb1;
                    bestA = wave_umax(bestA); bestB = wave_umax(bestB);
                    bestA = (unsigned)__builtin_amdgcn_readfirstlane((int)bestA); bestB = (unsigned)__builtin_amdgcn_readfirstlane((int)bestB);
                    const int sA = 127 - (int)(bestA & 127u), sB = 127 - (int)(bestB & 127u);
                    if (sA < 64) loA |= 1ull << sA; else hiA |= 1ull << (sA - 64);
                    if (sB < 64) loB |= 1ull << sB; else hiB |= 1ull << (sB - 64);
                    if (ka0 == bestA) ka0 = 0u; if (ka1 == bestA) ka1 = 0u; if (kb0 == bestB) kb0 = 0u; if (kb1 == bestB) kb1 = 0u;
                }
            }
            if (lane == 0) { sel[qi * 4 + 0] = (unsigned)loA; sel[qi * 4 + 1] = (unsigned)(loA >> 32); sel[qi * 4 + 2] = (unsigned)hiA; sel[qi * 4 + 3] = (unsigned)(hiA >> 32);
                             sel[(qi + 8) * 4 + 0] = (unsigned)loB; sel[(qi + 8) * 4 + 1] = (unsigned)(loB >> 32); sel[(qi + 8) * 4 + 2] = (unsigned)hiB; sel[(qi + 8) * 4 + 3] = (unsigned)(hiB >> 32); }
        }
    }
    { A_PTRS();
#pragma unroll
    for (int hh = 0; hh < 4; ++hh) { const float gt = gp[hh * 3 + 0];
#pragma unroll
        for (int dt = 0; dt < 4; ++dt) *(f32x4*)(scr + hh * 64 + dt * 16) = O[hh][dt] * gt; } }
    }
    {
        const bf16_t* Kg = P.ks + (size_t)(bg * SEQ) * 64; const bf16_t* Vg = P.VT + (size_t)(g * 64) * T + (size_t)b * SEQ;
        const size_t r0 = (size_t)b * SEQ + qlo;
        run_branch_sel(lds, Kg, Vg, T, 2 * iu + 1, P.q + r0 * 512 + g * 256, P.gates + r0 * 24 + g * 12, P.onsa + r0 * 512 + g * 256, tid, w, lane, fr, fq, qlo, blkq);
    }
    {
        A_STATE();
        const bf16_t* Kg = P.kw + (size_t)(bg * SEQ) * 64; const bf16_t* Vg = P.VT + (size_t)(128 + g * 64) * T + (size_t)b * SEQ;
        A_RESET();
        const int jlo = 2 * iu - 8 < 0 ? 0 : 2 * iu - 8;
        run_branch<3>(lds, Kg, Vg, T, jlo, 2 * iu + 1, qf, O, m, l, invl, tid, w, lane, fr, fq, qlo, tq, blkq, 0ull, 0ull);
        A_FINL();
        A_PTRS(); bf16_t* op = P.onsa + rq_ * 512 + g * 256 + 4 * fq;
#pragma unroll
        for (int hh = 0; hh < 4; ++hh) { const float gt = gp[hh * 3 + 2] * invl[hh];
#pragma unroll
            for (int dt = 0; dt < 4; ++dt) { const u32x2 pk_ = *(const u32x2*)(op + hh * 64 + dt * 16); const f32x4 sel_ = {bf_lo(pk_.x), bf_hi(pk_.x), bf_lo(pk_.y), bf_hi(pk_.y)};
                const f32x4 r = *(const f32x4*)(scr + hh * 64 + dt * 16) + sel_ + O[hh][dt] * gt; *(u32x2*)(op + hh * 64 + dt * 16) = pack4(r); } }
    }
#undef A_STATE
#undef A_PTRS
#undef A_RESET
#undef A_FINL
}

#define XB_TMO      128
#define XB_XCNT(j)  (256  + 64 * (j))
#define XB_XSUB(j)  (1280 + 64 * (j))
#define XB_XGEN(j)  (2304 + 64 * (j))
#define XB_TOP      3328
#define XB_TOPGEN   3392
#define XCD_BAR_WORDS 3456
#define XB_SPIN_CAP (1u << 18)

__device__ __forceinline__ unsigned xb_ld(unsigned* p)              { return __hip_atomic_load(p, __ATOMIC_RELAXED, __HIP_MEMORY_SCOPE_AGENT); }
__device__ __forceinline__ unsigned xb_add(unsigned* p, unsigned v) { return __hip_atomic_fetch_add(p, v, __ATOMIC_RELAXED, __HIP_MEMORY_SCOPE_AGENT); }
__device__ __forceinline__ unsigned xb_xcc_id() { return (unsigned)__builtin_amdgcn_s_getreg((3 << 11) | 20) & 0xFu; }
#define XB_SPIN(cond, bar) do { unsigned _sp = 0; while (cond) { __builtin_amdgcn_s_sleep(1); \
    if ((++_sp & 255u) == 0u) { if (xb_ld(&(bar)[XB_TMO])) break; if (_sp > XB_SPIN_CAP) { atomicAdd(&(bar)[XB_TMO], 1u); break; } } } } while (0)

struct XcdBarrier {
    unsigned* bar; unsigned x;
    volatile LAS unsigned* st;
};

__device__ __forceinline__ XcdBarrier xcd_barrier_post(unsigned* bar, volatile LAS unsigned* st) {
    XcdBarrier b; b.bar = bar; b.x = xb_xcc_id(); b.st = st;
    if (threadIdx.x == 0) (void)xb_add(&bar[XB_XCNT(b.x)], 1u);
    return b;
}
__device__ __forceinline__ void xcd_barrier_complete(unsigned* bar, unsigned x, unsigned& nloc, unsigned& nx) {
    const unsigned G = gridDim.x * gridDim.y * gridDim.z;
    unsigned sum, cnt, mine, sp = 0u;
    for (;;) {
        sum = 0u; cnt = 0u; mine = 0u;
#pragma unroll
        for (unsigned j = 0; j < 16; ++j) { const unsigned c = xb_ld(&bar[XB_XCNT(j)]); sum += c; cnt += (c > 0u) ? 1u : 0u; mine = (j == x) ? c : mine; }
        if (sum == G) break;
        __builtin_amdgcn_s_sleep(1);
        if ((++sp & 255u) == 0u) { if (xb_ld(&bar[XB_TMO])) break; if (sp > XB_SPIN_CAP) { atomicAdd(&bar[XB_TMO], 1u); break; } }
    }
    nloc = mine > 0u ? mine : 1u; nx = cnt > 0u ? cnt : 1u;
}

__device__ __forceinline__ void xcd_barrier(const XcdBarrier& b) {
    asm volatile("s_waitcnt vmcnt(0)" ::: "memory");
    __syncthreads();
    if (threadIdx.x == 0) {
        unsigned* bar = b.bar;
        __builtin_amdgcn_s_waitcnt(0);
        unsigned nloc = b.st[0], nx = b.st[1];
        if (nloc == 0u) { xcd_barrier_complete(bar, b.x, nloc, nx); b.st[0] = nloc; b.st[1] = nx; }
        const unsigned old = xb_add(&bar[XB_XSUB(b.x)], 1u);
        const unsigned gen = old / nloc;
        if (old + 1u == (gen + 1u) * nloc) {
            __builtin_amdgcn_fence(__ATOMIC_RELEASE, "agent");
            asm volatile("s_waitcnt vmcnt(0)" ::: "memory");
            const unsigned og = xb_add(&bar[XB_TOP], 1u);
            const unsigned tg = og / nx;
            if (og + 1u == (tg + 1u) * nx) xb_add(&bar[XB_TOPGEN], 1u);
            else XB_SPIN(xb_ld(&bar[XB_TOPGEN]) == tg, bar);
            __builtin_amdgcn_fence(__ATOMIC_ACQUIRE, "agent");
            xb_add(&bar[XB_XGEN(b.x)], 1u);
            asm volatile("s_waitcnt vmcnt(0)" ::: "memory");
        } else {
            XB_SPIN(xb_ld(&bar[XB_XGEN(b.x)]) == gen, bar);
            __builtin_amdgcn_fence(__ATOMIC_ACQUIRE, "agent");
            asm volatile("s_waitcnt vmcnt(0)" ::: "memory");
        }
    }
    __syncthreads();
}

struct Args { const void* in[30]; float* out; unsigned char* ws; double invf[32]; int ph_lo, ph_hi; };

enum { PH_PRO = 0, PH_F1UP, PH_F1DN, PH_WIN, PH_WVT, PH_C1K, PH_C2K, PH_C1V, PH_C2V, PH_CONV, PH_PCONV, PH_ATTN, PH_GA, PH_PA, PH_GB, PH_PB, PH_WO, PH_F2UP, PH_F2DN, PH_PP, PH_PG, PH_FNORM, PH_N };
__host__ __device__ inline bool sync_after(int k) { return !(k == PH_WIN || k == PH_C1K || k == PH_C1V || k == PH_C2K || k == PH_C2V || k == PH_CONV || k == PH_GA || k == PH_PA || (k == PH_GB && !(DBG_GATE >= 1 && DBG_GATE <= 4)) || k == PH_PP || k == PH_FNORM); }

__global__ void __launch_bounds__(512, 2) fwd_kernel(Args a) {
    extern __shared__ __attribute__((aligned(16))) unsigned char lds_raw[];
    LAS unsigned char* lds = (LAS unsigned char*)lds_raw;
    const int G = gridDim.x, bid = blockIdx.x, NGW = G * NWAVES;
    unsigned char* ws = a.ws;
    const float* x = (const float*)a.in[0]; const float* pin = (const float*)a.in[1]; const int* positions = (const int*)a.in[2];
    float* H = (float*)(ws + WS_H); bf16_t* U = (bf16_t*)(ws + WS_U); bf16_t* HID = (bf16_t*)(ws + WS_BIG);

#if !SPLIT_LAUNCH
    volatile LAS unsigned* bar_st = (volatile LAS unsigned*)(lds + 139264);
    if (threadIdx.x < 2) bar_st[threadIdx.x] = 0u;
    __syncthreads();
    XcdBarrier xbar = xcd_barrier_post((unsigned*)ws + 1024, bar_st);
#endif
#ifndef REP_PRO_N
#define REP_PRO_N 0
#endif
#ifndef PRO_SKIP_T
#define PRO_SKIP_T 0
#endif
    for (int it_ = a.ph_lo - REP_PRO_N; it_ < a.ph_hi; ++it_) { const int ph = it_ < 0 ? 0 : it_;
        int tid = threadIdx.x; asm volatile("" : "+v"(tid));
        const int lane = tid & 63, wave = __builtin_amdgcn_readfirstlane(tid >> 6), gw = bid * NWAVES + wave;
        Job J; J.A = nullptr; J.Bt = nullptr; J.M = 0; J.N = 0; J.K = 0; J.lda = 0; J.kind = -1; J.rot = 0; J.p0 = nullptr; J.p1 = nullptr; J.p2 = nullptr; J.scale = 1.f;
        switch (ph) {
        case PH_F1UP: J.A = U; J.Bt = (bf16_t*)(ws + WS_F1UP); J.M = T; J.N = 2 * FF; J.K = DM; J.lda = DM; J.kind = K_SWIGLU; J.p0 = HID; break;
        case PH_F1DN: J.A = HID; J.Bt = (bf16_t*)(ws + WS_F1DN); J.M = T; J.N = DM; J.K = FF; J.lda = FF; J.kind = K_RESID; J.p0 = (void*)x; J.p1 = H; J.scale = 0.5f; break;
        case PH_WIN: J.A = U; J.Bt = (bf16_t*)(ws + WS_WIN); J.M = T; J.N = 2816; J.K = DM; J.lda = DM; J.kind = K_WIN; break;
        case PH_WVT: J.A = (bf16_t*)(ws + WS_WVT); J.Bt = U; J.M = 256; J.N = T; J.K = DM; J.lda = DM; J.kind = K_VT; J.rot = 128; J.p0 = ws + WS_VT; break;
        case PH_C1K: J.A = (bf16_t*)(ws + WS_KCR); J.Bt = (bf16_t*)(ws + WS_CK1); J.M = 4096; J.N = 256; J.K = 2048; J.lda = 1024; J.kind = K_GELU; J.p0 = ws + WS_HCK; J.p1 = ws + WS_BIASK; break;
        case PH_C1V: J.A = (bf16_t*)(ws + WS_VCR); J.Bt = (bf16_t*)(ws + WS_CV1); J.M = 4096; J.N = 256; J.K = 2048; J.lda = 1024; J.kind = K_GELU; J.rot = 16; J.p0 = ws + WS_HCV; J.p1 = ws + WS_BIASV; break;
        case PH_C2K: J.A = (bf16_t*)(ws + WS_HCK); J.Bt = (bf16_t*)(ws + WS_CK2); J.M = 4096; J.N = 256; J.K = 256; J.lda = 256; J.kind = K_KC; J.p0 = ws + WS_KCOMP; break;
        case PH_C2V: J.A = (bf16_t*)(ws + WS_CV2); J.Bt = (bf16_t*)(ws + WS_HCV); J.M = 256; J.N = 4096; J.K = 256; J.lda = 256; J.kind = K_VCT; J.rot = 16; J.p0 = ws + WS_VCOMPT; break;
        case PH_GA: J.A = U; J.Bt = (bf16_t*)(ws + WS_WGA); J.M = T; J.N = DM; J.K = DM; J.lda = DM; J.kind = K_SIG; J.p0 = ws + WS_SGA; break;
        case PH_PA: J.A = (bf16_t*)(ws + WS_ONSA); J.Bt = (bf16_t*)(ws + WS_PA); J.M = T; J.N = DM; J.K = 512; J.lda = 512; J.kind = K_PROJA; J.p0 = ws + WS_SGA; break;
        case PH_GB: J.A = U; J.Bt = (bf16_t*)(ws + WS_WGB); J.M = T; J.N = DM; J.K = DM; J.lda = DM; J.kind = K_SIG; J.p0 = ws + WS_SGB; break;
        case PH_PB: J.A = (bf16_t*)(ws + WS_OCONV); J.Bt = (bf16_t*)(ws + WS_PB); J.M = T; J.N = DM; J.K = 512; J.lda = 512; J.kind = K_PROJB; J.p0 = ws + WS_SGB; J.p1 = ws + WS_SGA; break;
        case PH_WO: J.A = (bf16_t*)(ws + WS_SGB); J.Bt = (bf16_t*)(ws + WS_WO); J.M = T; J.N = DM; J.K = DM; J.lda = DM; J.kind = K_RESID; J.p0 = H; J.p1 = H; J.scale = 1.f; break;
        case PH_F2UP: J.A = U; J.Bt = (bf16_t*)(ws + WS_F2UP); J.M = T; J.N = 2 * FF; J.K = DM; J.lda = DM; J.kind = K_SWIGLU; J.p0 = HID; break;
        case PH_F2DN: J.A = HID; J.Bt = (bf16_t*)(ws + WS_F2DN); J.M = T; J.N = DM; J.K = FF; J.lda = FF; J.kind = K_RESID; J.p0 = H; J.p1 = H; J.scale = 0.5f; break;
        case PH_PP: J.A = (bf16_t*)(ws + WS_PBF); J.Bt = (bf16_t*)(ws + WS_PP); J.M = T; J.N = DM; J.K = 256; J.lda = 256; J.kind = K_ST32; J.p0 = ws + WS_TMP; break;
        case PH_PG: J.A = U; J.Bt = (bf16_t*)(ws + WS_PG); J.M = T; J.N = DM; J.K = DM; J.lda = DM; J.kind = K_PLE; J.p0 = H; J.p1 = ws + WS_TMP; break;
        default: break;
        }
        J.rowss = nullptr; J.ssout = nullptr;
        { float* ssq = (float*)(ws + WS_SUMSQ);
          switch (ph) {
          case PH_F1DN: J.p2 = U; J.ssout = ssq; break;
          case PH_WIN: case PH_WVT: case PH_GA: case PH_GB: J.rowss = ssq; break;
          case PH_WO: J.p2 = U; J.ssout = ssq + T; break;
          case PH_F2UP: J.rowss = ssq + T; break;
          case PH_F2DN: J.p2 = U; J.ssout = ssq + 2 * T; break;
          case PH_PG: J.rowss = ssq + 2 * T; break;
          default: break; } }
#if DBG_GATE
        if (ph == PH_PRO && bid == 0 && tid == 0) { *(unsigned*)ws = 0u; ((unsigned*)ws)[1] = 0u; }
#if DBG_GATE == 2
        if (ph == PH_C1K && bid < 4) {
            const int sidx = bid * 512 + tid; const int row = (int)(((long long)sidx * 7919) % T), col = (int)(((long long)sidx * 104729) % 512);
            const float* win = (const float*)a.in[8]; float g = 0.f;
            for (int k = 0; k < DM; ++k) { const float wv = __uint_as_float(f2bf(win[(size_t)k * WIN_COLS + 1304 + col]) << 16); g += __uint_as_float((unsigned)U[(size_t)row * DM + k] << 16) * wv; }
            const float got = __uint_as_float((unsigned)((const bf16_t*)(ws + WS_CB))[(size_t)row * 512 + col] << 16);
            if (!(fabsf(g - got) < 0.03f + 0.01f * fabsf(g))) { atomicOr((unsigned*)ws, 1u); atomicAdd((unsigned*)ws + 1, 1u); }
        }
#endif
#if DBG_GATE == 5
        if (ph == PH_WO && bid < 4) {
            const int sidx = bid * 512 + tid; const int row = (int)(((long long)sidx * 7919) % T), col = (int)(((long long)sidx * 104729) % 1024);
            const float* win = (const float*)a.in[8]; const float* wb = (const float*)a.in[20]; float g = 0.f, v = 0.f;
            for (int k = 0; k < DM; ++k) { const float wv = __uint_as_float(f2bf(win[(size_t)k * WIN_COLS + 3864 + col]) << 16); g += __uint_as_float((unsigned)U[(size_t)row * DM + k] << 16) * wv; }
            const bf16_t* oc = (const bf16_t*)(ws + WS_OCONV);
            for (int k = 0; k < 512; ++k) { const float wv = __uint_as_float(f2bf(wb[(size_t)k * DM + col]) << 16); v += __uint_as_float((unsigned)oc[(size_t)row * 512 + k] << 16) * wv; }
            const float ref = v / (1.0f + expf(-g)); const float got = __uint_as_float((unsigned)((const bf16_t*)(ws + WS_SGB))[(size_t)row * DM + col] << 16);
            if (DBG_STRAT) { atomicOr((unsigned*)ws, 1u); if (!(fabsf(ref - got) < 0.03f + 0.02f * fabsf(ref))) atomicAdd((unsigned*)ws + 1, 1u); }
        }
#endif
#if DBG_GATE == 3
        if (ph == PH_GA && bid < 4) {
            const int sidx = bid * 512 + tid; const int row = (int)(((long long)sidx * 7919) % T), col = (int)(((long long)sidx * 104729) % 1024);
            float ss = 0.f; for (int k = 0; k < DM; ++k) { const float hv = H[(size_t)row * DM + k]; ss += hv * hv; }
            const float ref = H[(size_t)row * DM + col] * (1.0f / sqrtf(ss * (1.f / DM) + EPSN)) * ((const float*)a.in[7])[col];
            const float got = __uint_as_float((unsigned)U[(size_t)row * DM + col] << 16);
            if (!(fabsf(ref - got) < 0.02f + 0.01f * fabsf(ref))) { atomicOr((unsigned*)ws, 1u); atomicAdd((unsigned*)ws + 1, 1u); }
        }
#endif
        if ((DBG_GATE == 1 || DBG_GATE == 4) && ph == PH_PB) J.kind = -2;
        if ((DBG_GATE == 1 || DBG_GATE == 4) && ph == PH_PB && bid < 4) {
            const int sidx = bid * 512 + tid; const int row = (int)(((long long)sidx * 7919) % T), col = (int)(((long long)sidx * 104729) % 1024);
            const float* win = (const float*)a.in[8]; float g = 0.f;
            for (int k = 0; k < DM; ++k) { const float wv = __uint_as_float(f2bf(win[(size_t)k * WIN_COLS + 3864 + col]) << 16); g += __uint_as_float((unsigned)U[(size_t)row * DM + k] << 16) * wv; }
            const float ref = 1.0f / (1.0f + expf(-g)); const float got = __uint_as_float((unsigned)((const bf16_t*)(ws + WS_SGB))[(size_t)row * DM + col] << 16);
#if DBG_GATE == 4
            if (fabsf(g) > 3.0f) { atomicOr((unsigned*)ws, 1u); atomicAdd((unsigned*)ws + 1, 1u); }
#else
            if (DBG_STRAT) { atomicOr((unsigned*)ws, 1u); if (!(fabsf(ref - got) < 0.03f)) atomicAdd((unsigned*)ws + 1, 1u); }
#endif
            { const bf16_t* wt = (const bf16_t*)(ws + WS_WGB); bool bad = false;
              for (int k = 0; k < DM; k += 37) { if (wt[(size_t)col * DM + k] != (bf16_t)f2bf(win[(size_t)k * WIN_COLS + 3864 + col])) bad = true; }
              if (bad) atomicOr((unsigned*)ws, 2u); }
        }
        if (ph == PH_FNORM) { if (*(volatile unsigned*)ws != 0u) { for (int row = gw; row < T; row += NGW) for (int j = 0; j < 4; ++j) { const float fv = (*(volatile unsigned*)ws & 2u) ? 100.f : 1.0f + 9.0f * (float)((volatile unsigned*)ws)[1] / 2048.0f; ((f32x4*)(a.out + (size_t)row * DM))[lane + 64 * j] = (f32x4){fv, fv, fv, fv}; } continue; } }
#endif
#ifdef SKIP_PH
        if (((SKIP_PH) >> ph) & 1) J.kind = -2;
#endif
        if (J.kind >= 0) {
            EpiSwitch E; E.J = J;
            E.W.ws = ws; E.W.sg = nullptr;
            pg8::Gemm g{J.A, J.Bt, J.M, J.N, J.K, J.lda}; pg8::StaticOrder S; S.init(J.M, J.N, G, (bid + J.rot) % G);
#ifndef NO_GEMM
            pg8::gemm_phase<EpiSwitch, pg8::StaticOrder, GP_ALIGN, GP_SP2>(lds, g, S, E);
#endif
#ifdef REP_PH
            if (ph == REP_PH) pg8::gemm_phase<EpiSwitch, pg8::StaticOrder, GP_ALIGN, GP_SP2>(lds, g, S, E);
#endif
        } else if (ph == PH_PRO) {
            LAS float* scr = (LAS float*)(lds + wave * 17024);
            int base = 0;
#pragma unroll
            for (int jb = 0; jb < 17; ++jb) {
                const float* W0 = nullptr; const float* W1 = nullptr; const float* gn = nullptr; int K = 0, N = 0, P = 0, pk = PK_ID; size_t dst = 0;
                switch (jb) {
                case 0: W0 = (const float*)a.in[4]; W1 = (const float*)a.in[5]; K = DM; N = FF; P = 2 * FF; pk = PK_SWIGLU; dst = WS_F1UP; break;
                case 1: W0 = (const float*)a.in[6]; K = FF; N = DM; P = DM; dst = WS_F1DN; break;
                case 2: gn = (const float*)a.in[22]; W0 = (const float*)a.in[23]; W1 = (const float*)a.in[24]; K = DM; N = FF; P = 2 * FF; pk = PK_SWIGLU; dst = WS_F2UP; break;
                case 3: W0 = (const float*)a.in[25]; K = FF; N = DM; P = DM; dst = WS_F2DN; break;
                case 4: gn = (const float*)a.in[7]; W0 = (const float*)a.in[8]; K = DM; N = WIN_COLS; P = 2816; pk = PK_WIN; dst = WS_WIN; break;
                case 15: gn = (const float*)a.in[7]; W0 = (const float*)a.in[8]; K = DM; N = WIN_COLS; P = DM; pk = PK_GA; dst = WS_WGA; break;
                case 16: gn = (const float*)a.in[7]; W0 = (const float*)a.in[8]; K = DM; N = WIN_COLS; P = DM; pk = PK_GB; dst = WS_WGB; break;
                case 5: gn = (const float*)a.in[7]; W0 = (const float*)a.in[8]; K = DM; N = WIN_COLS; P = 256; pk = PK_VT; dst = WS_WVT; break;
                case 6: W0 = (const float*)a.in[10]; K = 2048; N = 256; P = 256; dst = WS_CK1; break;
                case 7: W0 = (const float*)a.in[14]; K = 2048; N = 256; P = 256; dst = WS_CV1; break;
                case 8: W0 = (const float*)a.in[12]; K = 256; N = 64; P = 256; pk = PK_PAD64; dst = WS_CK2; break;
                case 9: W0 = (const float*)a.in[16]; K = 256; N = 64; P = 256; pk = PK_PAD64; dst = WS_CV2; break;
                case 10: W0 = (const float*)a.in[19]; K = 512; N = DM; P = DM; dst = WS_PA; break;
                case 11: W0 = (const float*)a.in[20]; K = 512; N = DM; P = DM; dst = WS_PB; break;
                case 12: W0 = (const float*)a.in[21]; K = DM; N = DM; P = DM; dst = WS_WO; break;
                case 13: gn = (const float*)a.in[26]; W0 = (const float*)a.in[27]; K = DM; N = DM; P = DM; dst = WS_PG; break;
                case 14: W0 = (const float*)a.in[28]; K = 256; N = DM; P = DM; dst = WS_PP; break;
                }
                const int nblk = P / 64, nitems = (K / 64) * nblk;
                int first = (gw - base) % NGW; if (first < 0) first += NGW;
                if (!(PRO_SKIP_T && it_ < 0)) for (int it = first; it < nitems; it += NGW) transpose_item(W0, W1, gn, K, N, pk, (bf16_t*)(ws + dst), scr, it, nblk, lane);
                base += nitems;
            }
            for (int ib = bid * 512; ib < 3 * T; ib += G * 512) ((float*)(ws + WS_SUMSQ))[ib + tid] = 0.f;
            for (int ibs = bid * 512; ibs < T * 32; ibs += 4 * G * 512) { const int ib = ibs + tid;
                int pr[4];
#pragma unroll
                for (int k = 0; k < 4; ++k) { const int idx = ib + k * G * 512; pr[k] = idx < T * 32 ? positions[idx >> 5] : 0; }
#pragma unroll
                for (int k = 0; k < 4; ++k) { const int idx = ib + k * G * 512;
                    if (idx < T * 32) {
                        const double ang = (double)pr[k] * a.invf[idx & 31];
                        const double kk = rint(ang * 0.15915494309189535);
                        double r = fma(-kk, 6.283185307179586, ang); r = fma(-kk, 2.4492935982947064e-16, r);
                        const float rf = (float)r;
                        float2 cs; cs.x = cosf(rf); cs.y = sinf(rf);
                        ((float2*)(ws + WS_ROPE))[idx] = cs; }
                    asm volatile("" ::: "memory"); }
            }
            for (int ob = bid; ob < 256; ob += G) {
                const int mat = ob >> 7, n0 = (ob & 127) * 2;
                const float* posk = (const float*)a.in[9]; const float* posv = (const float*)a.in[13]; const float* w1k = (const float*)a.in[10]; const float* w1v = (const float*)a.in[14]; const float* b1k = (const float*)a.in[11]; const float* b1v = (const float*)a.in[15];
                const float* pos = mat ? posv : posk; const float* w1 = mat ? w1v : w1k; const float* b1 = mat ? b1v : b1k;
                float s0 = 0.f, s1 = 0.f;
#pragma unroll
                for (int i = 0; i < 4; ++i) { const int kk = tid * 4 + i; const float pv = pos[kk]; const float2 wv = *(const float2*)(w1 + (size_t)kk * 256 + n0); s0 += pv * wv.x; s1 += pv * wv.y; }
                s0 = wave_sum(s0); s1 = wave_sum(s1);
                LAS float* red = (LAS float*)(lds + 137216);
                __syncthreads();
                if (lane == 0) { red[wave * 2] = s0; red[wave * 2 + 1] = s1; }
                __syncthreads();
                if (tid < 2) { float tsum = b1[n0 + tid]; for (int q = 0; q < 8; ++q) tsum += red[q * 2 + tid]; ((float*)(ws + (mat ? WS_BIASV : WS_BIASK)))[n0 + tid] = tsum; }
            }
            for (int row = gw; row < T; row += 4 * NGW) norm_rows_n<false, 4>(x, (const float*)a.in[3], U, row, NGW, lane);
        } else if ((ph == PH_PCONV || ph == PH_CONV) && G == 256 && (bid < 16 || bid >= 240)) {
        } else if (ph == PH_PCONV) {
            bf16_t* pb = (bf16_t*)(ws + WS_PBF);
            const int eb = (G == 256) ? bid - 16 : bid, EG = (G == 256) ? 224 : G;
            for (size_t i8 = (size_t)eb * 512 + tid; i8 < (size_t)T * 256 / 8; i8 += (size_t)EG * 512) { const f32x4 v0 = ((const f32x4*)pin)[2 * i8], v1 = ((const f32x4*)pin)[2 * i8 + 1]; ((u32x4*)pb)[i8] = pack8(v0, v1); }
        } else if (ph == PH_FNORM) {
            for (int row = gw; row < T; row += 4 * NGW) norm_rows_n<true, 4>(H, (const float*)a.in[29], a.out, row, NGW, lane);
        } else if (ph == PH_CONV) {
            const bf16_t* cb = (const bf16_t*)(ws + WS_CB); const bf16_t* cc = cb + (size_t)T * 512; const bf16_t* cx = cc + (size_t)T * 512; bf16_t* oc = (bf16_t*)(ws + WS_OCONV);
            const float* cw = (const float*)a.in[17]; const float* cbias = (const float*)a.in[18];
            const int eb = (G == 256) ? bid - 16 : bid, EG = (G == 256) ? 224 : G;
            for (int it = eb * 512 + tid; it < (T / 16) * 64; it += EG * 512) {
                const int c0 = (it & 63) * 8, tc0 = (it >> 6) * 16;
                f32x4 w0a = *(const f32x4*)(cw + c0), w0b = *(const f32x4*)(cw + c0 + 4), w1a = *(const f32x4*)(cw + 512 + c0), w1b = *(const f32x4*)(cw + 512 + c0 + 4);
                f32x4 w2a = *(const f32x4*)(cw + 1024 + c0), w2b = *(const f32x4*)(cw + 1024 + c0 + 4), bia = *(const f32x4*)(cbias + c0), bib = *(const f32x4*)(cbias + c0 + 4);
                f32x4 u2a = {0.f, 0.f, 0.f, 0.f}, u2b = u2a, u1a = u2a, u1b = u2a;
                if ((tc0 & (SEQ - 1)) != 0) {
                    f32x4 ca, cbb, xa, xb;
                    unpack8(*(const u32x4*)(cc + (size_t)(tc0 - 2) * 512 + c0), ca, cbb); unpack8(*(const u32x4*)(cx + (size_t)(tc0 - 2) * 512 + c0), xa, xb); u2a = ca * xa; u2b = cbb * xb;
                    unpack8(*(const u32x4*)(cc + (size_t)(tc0 - 1) * 512 + c0), ca, cbb); unpack8(*(const u32x4*)(cx + (size_t)(tc0 - 1) * 512 + c0), xa, xb); u1a = ca * xa; u1b = cbb * xb;
                }
                u32x4 ncc = *(const u32x4*)(cc + (size_t)tc0 * 512 + c0), ncx = *(const u32x4*)(cx + (size_t)tc0 * 512 + c0), ncb = *(const u32x4*)(cb + (size_t)tc0 * 512 + c0);
#pragma unroll 4
                for (int tt = 0; tt < 16; ++tt) {
                    const size_t o = (size_t)(tc0 + tt) * 512 + c0;
                    const u32x4 wcc = ncc, wcx = ncx, wcb = ncb;
                    if (tt < 15) { ncc = *(const u32x4*)(cc + o + 512); ncx = *(const u32x4*)(cx + o + 512); ncb = *(const u32x4*)(cb + o + 512); }
                    f32x4 ca, cbb, xa, xb, ba, bb;
                    unpack8(wcc, ca, cbb); unpack8(wcx, xa, xb); unpack8(wcb, ba, bb);
                    const f32x4 u0a = ca * xa, u0b = cbb * xb;
                    const f32x4 ya = w0a * u2a + w1a * u1a + w2a * u0a + bia, yb = w0b * u2b + w1b * u1b + w2b * u0b + bib;
                    *(u32x4*)(oc + o) = pack8(ba * ya, bb * yb);
                    u2a = u1a; u2b = u1b; u1a = u0a; u1b = u0b;
                }
            }
        } else if (ph == PH_ATTN) {
            AttnP P; P.q = (const bf16_t*)(ws + WS_Q); P.kcomp = (const bf16_t*)(ws + WS_KCOMP); P.vcompT = (const bf16_t*)(ws + WS_VCOMPT); P.ks = (const bf16_t*)(ws + WS_KS); P.kw = (const bf16_t*)(ws + WS_KW);
            P.VT = (const bf16_t*)(ws + WS_VT); P.gates = (const float*)(ws + WS_GATES); P.scratch = (float*)(ws + WS_CB); P.scratch2 = nullptr; P.onsa = (bf16_t*)(ws + WS_ONSA);
#ifdef ZERO_ATTN
            for (size_t i8 = (size_t)bid * 512 + tid; i8 < (size_t)T * 512 / 8; i8 += (size_t)G * 512) ((u32x4*)P.onsa)[i8] = (u32x4){0u, 0u, 0u, 0u};
#endif
#if !defined(NO_ATTN) && !defined(ZERO_ATTN)
            {
                if (wave >= 4) __builtin_amdgcn_s_setprio(1);
                unsigned* qctr = (unsigned*)ws + 6144; const int bgi = bid & 7;
                LAS unsigned* nxt = (LAS unsigned*)(lds + 140000);
                for (;;) {
                    if (tid == 0) nxt[0] = atomicAdd(qctr + 64 * bgi, 1u);
                    __syncthreads();
                    const unsigned un = nxt[0];
                    __syncthreads();
                    if (un >= 64u) break;
                    attn_unit(lds, P, bgi >> 1, bgi & 1, 63 - (int)un, tid, wave, lane);
                }
                __builtin_amdgcn_s_setprio(0);
            }
#endif

        }
#if !SPLIT_LAUNCH
        if (ph + 1 < a.ph_hi && sync_after(ph)) { if (a.ph_lo < 0) cg::this_grid().sync();   xcd_barrier(xbar); }
#endif
#ifdef SYNC_PROBE
        if (ph == PH_PRO) for (int i_ = 0; i_ < SYNC_PROBE; ++i_) cg::this_grid().sync();
#endif
    }
}

extern "C" void kernel_launch(void* const* d_in, const int* in_sizes, int n_in, void* d_out, int out_size, void* d_ws, size_t ws_size, hipStream_t stream) {
    static int grid = 0;
    if (grid == 0) {
        if (n_in != 30 || out_size != T * DM || ws_size < WS_END) { fprintf(stderr, "kernel_launch: unexpected problem (n_in %d out %d ws %zu)\n", n_in, out_size, ws_size); grid = -1; return; }
        {
            const long long exp_sz[30] = {(long long)T * DM, (long long)T * 256, T, DM, (long long)DM * FF, (long long)DM * FF, (long long)FF * DM, DM, (long long)DM * WIN_COLS, 2048, 2048 * 256, 256, 256 * 64,
                                          2048, 2048 * 256, 256, 256 * 64, 3 * 512, 512, 512 * DM, 512 * DM, (long long)DM * DM, DM, (long long)DM * FF, (long long)DM * FF, (long long)FF * DM, DM, (long long)DM * DM, 256 * DM, DM};
            for (int i = 0; i < 30; ++i) if ((long long)in_sizes[i] != exp_sz[i]) { fprintf(stderr, "kernel_launch: input %d has %d elements, expected %lld\n", i, in_sizes[i], exp_sz[i]); grid = -1; return; }
        }
        int dev = 0, cus = 0, per_cu = 0;
        hipGetDevice(&dev); hipDeviceGetAttribute(&cus, hipDeviceAttributeMultiprocessorCount, dev);
        if (hipFuncSetAttribute((const void*)fwd_kernel, hipFuncAttributeMaxDynamicSharedMemorySize, LDS_BYTES) != hipSuccess) { fprintf(stderr, "kernel_launch: hipFuncSetAttribute failed\n"); grid = -1; return; }
        if (hipOccupancyMaxActiveBlocksPerMultiprocessor(&per_cu, (const void*)fwd_kernel, 512, LDS_BYTES) != hipSuccess || per_cu < 1) { fprintf(stderr, "kernel_launch: occupancy query says %d\n", per_cu); per_cu = 1; }
        (void)hipGetLastError();
        grid = cus * per_cu;
    }
    if (grid < 0) return;
    Args a{};
    for (int i = 0; i < 30; ++i) a.in[i] = d_in[i];
    a.out = (float*)d_out; a.ws = (unsigned char*)d_ws;
    for (int f = 0; f < 32; ++f) a.invf[f] = pow(10000.0, -(double)f / 32.0);
#if SPLIT_LAUNCH
    int lo = 0;
    for (int k = 0; k < PH_N; ++k) if (sync_after(k) || k == PH_N - 1) { a.ph_lo = lo; a.ph_hi = k + 1; hipLaunchKernelGGL(fwd_kernel, dim3(grid), dim3(512), LDS_BYTES, stream, a); lo = k + 1; }
#else
    (void)hipMemsetAsync(d_ws, 0, 32768, stream);
    a.ph_lo = 0; a.ph_hi = PH_N;
    void* args[] = {&a};
    hipError_t e = hipLaunchCooperativeKernel((const void*)fwd_kernel, dim3(grid), dim3(512), args, LDS_BYTES, stream);
    if (e != hipSuccess) fprintf(stderr, "cooperative launch failed: %s (grid %d)\n", hipGetErrorString(e), grid);
#endif
}
```

```cpp
#include <hip/hip_runtime.h>
#include <hip/hip_cooperative_groups.h>
#include <cstdio>
#include <cstdint>
#include <cmath>
namespace cg = cooperative_groups;
#ifndef SPLIT_LAUNCH
#define SPLIT_LAUNCH 0
#endif
#ifndef EPI_DRAIN
#define EPI_DRAIN 0
#endif
#ifndef DBG_GATE
#define DBG_GATE 0
#endif
#ifndef DBG_STRAT
#define DBG_STRAT 1
#endif
#ifndef ATTN_REPS
#define ATTN_REPS 1
#endif
#ifndef GP_ALIGN
#define GP_ALIGN true
#endif
#ifndef GP_SP2
#define GP_SP2 true
#endif
namespace pg8 {
#define PG8_LAS __attribute__((address_space(3)))
typedef unsigned short bf16_t;
typedef short bf16x8 __attribute__((ext_vector_type(8)));
typedef float f32x4 __attribute__((ext_vector_type(4)));
typedef unsigned u32x4 __attribute__((ext_vector_type(4)));
constexpr int BM = 256, BK = 64, HALF = 128, HTB = HALF * BK * 2  , STAGE_BYTES = 8 * HTB, NXCD = 8, WGM = 4;

__host__ __device__ __forceinline__ int lds_byte(int r, int c) { const int st = (r >> 4) * 2 + (c >> 5), rr = r & 15, cc = c & 31, ob = rr * 64 + cc * 2; return st * 1024 + (ob ^ (((ob >> 9) & 1) << 5)); }
__host__ __device__ __forceinline__ void stage_rc(int b, int& R, int& C) { const int st = b / 1024, sb = b % 1024, swz = sb ^ (((sb >> 9) & 1) << 5); R = (st >> 1) * 16 + swz / 64; C = (st & 1) * 32 + (swz % 64) / 2; }
__host__ __device__ __forceinline__ int perm32(int rho) { const int n = rho >> 4, i = rho & 15; return 8 * (i >> 2) + 4 * n + (i & 3); }

struct Unit { int pm, pn; };
struct Gemm { const bf16_t* A; const bf16_t* Bt; int M, N, K, lda; };

struct StaticOrder {
    int nM, nN, nwg, G, c;
    __host__ __device__ void init(int M, int N, int G_, int c_) { nM = M / BM; nN = N / BM; nwg = nM * nN; G = G_; c = c_; }
    __host__ __device__ bool next(int i, Unit& u) const {
        const long L = (long)i * G + c; if (L >= nwg) return false;
        int wgid = (int)L; { const int q = nwg / NXCD, r = nwg % NXCD, xcd = wgid % NXCD, off = wgid / NXCD; wgid = (xcd < r ? xcd * (q + 1) : r * (q + 1) + (xcd - r) * q) + off; }
        const int nig = WGM * nN, gid = wgid / nig, fm = gid * WGM, gsz = (nM - fm) < WGM ? (nM - fm) : WGM;
        u.pm = fm + ((wgid % nig) % gsz); u.pn = (wgid % nig) / gsz; return true;
    }
    __device__ __forceinline__ void a_ready(const Unit&) const {}
    __device__ __forceinline__ void done(const Unit&) const {}
};

template <class Epi, class Sched, bool ALIGN_EPI = false, bool SP2 = false>
__device__ __forceinline__ void gemm_phase(PG8_LAS unsigned char* lds, const Gemm g, const Sched& S, const Epi& E) {
    int tid_ = threadIdx.x; asm volatile("" : "+v"(tid_));
    const int tid = tid_, wid = __builtin_amdgcn_readfirstlane(tid >> 6), lane = tid & 63, wr = wid >> 2, wc = wid & 3, fr = lane & 15, fq = lane >> 4;
    const int K = g.K, nt = K / BK;
    unsigned voffA[2], voffB[2];
#pragma unroll
    for (int i = 0; i < 2; ++i) { int R, C; stage_rc(tid * 16 + i * 8192, R, C); const int Rb = Epi::PERM ? ((R & ~31) + perm32(R & 31)) : R;
        voffA[i] = (unsigned)(R * g.lda + C) * 2u; voffB[i] = (unsigned)(Rb * K + C) * 2u; }
    const size_t kstep = (size_t)(BK * 2);
    const size_t hstepA = (size_t)HALF * g.lda * 2, hstepB = (size_t)HALF * K * 2;
    const size_t tstepA = 2 * hstepA, tstepB = 2 * hstepB;
    const unsigned ldsw = (unsigned)wid * 1024u;
    const int aoff = lds_byte(wr * 64 + fr, fq * 8), boff = lds_byte(wc * 32 + fr, fq * 8);
#define PG8_SA(b, h) (((b) * 2 + (h)) * HTB)
#define PG8_SB(b, h) ((4 + (b) * 2 + (h)) * HTB)
#define PG8_STAGE(bufoff, gbase, voff) do { _Pragma("unroll") for (int _i = 0; _i < 2; ++_i) \
        __builtin_amdgcn_global_load_lds((const unsigned*)((const char*)(gbase) + (voff)[_i]), (PG8_LAS unsigned*)(lds + (bufoff) + ldsw + _i * 8192), 16, 0, 0); } while (0)
#define PG8_LDA(dst, b, h) do { _Pragma("unroll") for (int m = 0; m < 4; ++m) _Pragma("unroll") for (int k = 0; k < 2; ++k) dst[m][k] = *(const PG8_LAS bf16x8*)(lds + PG8_SA(b, h) + aoff + m * 2048 + k * 1024); } while (0)
#define PG8_LDB(dst, b, h) do { _Pragma("unroll") for (int n = 0; n < 2; ++n) _Pragma("unroll") for (int k = 0; k < 2; ++k) dst[n][k] = *(const PG8_LAS bf16x8*)(lds + PG8_SB(b, h) + boff + n * 2048 + k * 1024); } while (0)
#define PG8_MMA(ai, bj, At, Bt) do { __builtin_amdgcn_s_setprio(1); _Pragma("unroll") for (int m = 0; m < 4; ++m) _Pragma("unroll") for (int n = 0; n < 2; ++n) _Pragma("unroll") for (int k = 0; k < 2; ++k) \
        acc[ai][bj][m][n] = __builtin_amdgcn_mfma_f32_16x16x32_bf16(Bt[n][k], At[m][k], acc[ai][bj][m][n], 0, 0, 0); __builtin_amdgcn_s_setprio(0); } while (0)
#define PG8_WAIT_V(n) asm volatile("s_waitcnt vmcnt(" #n ")" ::: "memory")
#define PG8_WAIT_L(n) asm volatile("s_waitcnt lgkmcnt(" #n ")" ::: "memory")
#define PG8_BAR __builtin_amdgcn_s_barrier()
#define PG8_SCHED __builtin_amdgcn_sched_barrier(0)
    Unit cur, nxt; int ui = 0;
    if (!S.next(0, cur)) return;
    f32x4 acc[2][2][4][2];
#pragma unroll
    for (int a = 0; a < 2; ++a)
#pragma unroll
        for (int b = 0; b < 2; ++b)
#pragma unroll
            for (int m = 0; m < 4; ++m)
#pragma unroll
                for (int n = 0; n < 2; ++n) acc[a][b][m][n] = (f32x4){0.f, 0.f, 0.f, 0.f};
    bf16x8 At[4][2], B0[2][2], B1[2][2];
    const char* cA = (const char*)g.A + (size_t)cur.pm * tstepA; const char* cB = (const char*)g.Bt + (size_t)cur.pn * tstepB;
    S.a_ready(cur);
    if constexpr (SP2) {
        PG8_STAGE(PG8_SB(0, 0), cB, voffB); PG8_STAGE(PG8_SB(0, 1), cB + hstepB, voffB); PG8_STAGE(PG8_SA(0, 0), cA, voffA); PG8_STAGE(PG8_SA(0, 1), cA + hstepA, voffA);
        if (wr == 1) PG8_BAR;
        PG8_WAIT_V(2); PG8_BAR;
        PG8_STAGE(PG8_SB(1, 0), cB + kstep, voffB); PG8_STAGE(PG8_SA(1, 0), cA + kstep, voffA); PG8_STAGE(PG8_SB(1, 1), cB + hstepB + kstep, voffB);
        PG8_WAIT_V(6); PG8_BAR;
    } else {
        PG8_STAGE(PG8_SB(0, 0), cB, voffB); PG8_STAGE(PG8_SA(0, 0), cA, voffA); PG8_STAGE(PG8_SB(0, 1), cB + hstepB, voffB); PG8_STAGE(PG8_SA(0, 1), cA + hstepA, voffA);
        if (wr == 1) PG8_BAR;
        PG8_WAIT_V(4); PG8_BAR;
        PG8_STAGE(PG8_SB(1, 0), cB + kstep, voffB); PG8_STAGE(PG8_SA(1, 0), cA + kstep, voffA); PG8_STAGE(PG8_SB(1, 1), cB + hstepB + kstep, voffB);
        PG8_WAIT_V(6); PG8_BAR;
    }
    for (;;) {
        const bool has_next = S.next(ui + 1, nxt);
        const char* nA = has_next ? (const char*)g.A + (size_t)nxt.pm * tstepA : cA; const char* nB = has_next ? (const char*)g.Bt + (size_t)nxt.pn * tstepB : cB;
        for (int t = 0; t < nt; t += 2) {
            const bool last = (t == nt - 2);
            const char* a1 = cA + (size_t)(t + 1) * kstep;
            const char* a2 = last ? nA : cA + (size_t)(t + 2) * kstep; const char* b2 = last ? nB : cB + (size_t)(t + 2) * kstep;
            const char* a3 = a2 + kstep; const char* b3 = b2 + kstep;
            if (last && has_next) S.a_ready(nxt);
            if constexpr (SP2) {
            PG8_LDB(B0, 0, 0); PG8_LDB(B1, 0, 1); PG8_SCHED; PG8_LDA(At, 0, 0); PG8_STAGE(PG8_SA(1, 1), a1 + hstepA, voffA);
            PG8_WAIT_V(8); PG8_WAIT_L(0); PG8_BAR; PG8_MMA(0, 0, At, B0); PG8_MMA(0, 1, At, B1); PG8_BAR; PG8_SCHED;
            PG8_LDA(At, 0, 1); PG8_STAGE(PG8_SB(0, 0), b2, voffB); PG8_STAGE(PG8_SB(0, 1), b2 + hstepB, voffB); PG8_STAGE(PG8_SA(0, 0), a2, voffA);
            PG8_WAIT_V(8); PG8_WAIT_L(0); PG8_BAR; PG8_MMA(1, 0, At, B0); PG8_MMA(1, 1, At, B1); PG8_BAR; PG8_SCHED;
            PG8_LDB(B0, 1, 0); PG8_LDB(B1, 1, 1); PG8_SCHED; PG8_LDA(At, 1, 0); PG8_STAGE(PG8_SA(0, 1), a2 + hstepA, voffA);
            PG8_WAIT_V(8); PG8_WAIT_L(0); PG8_BAR; PG8_MMA(0, 0, At, B0); PG8_MMA(0, 1, At, B1); PG8_BAR; PG8_SCHED;
            PG8_LDA(At, 1, 1); PG8_STAGE(PG8_SB(1, 0), b3, voffB); PG8_STAGE(PG8_SB(1, 1), b3 + hstepB, voffB); PG8_STAGE(PG8_SA(1, 0), a3, voffA);
            PG8_WAIT_V(8); PG8_WAIT_L(0); PG8_BAR; PG8_MMA(1, 0, At, B0); PG8_MMA(1, 1, At, B1); PG8_BAR; PG8_SCHED;
            } else {
            PG8_LDB(B0, 0, 0); PG8_SCHED; PG8_LDA(At, 0, 0); PG8_STAGE(PG8_SA(1, 1), a1 + hstepA, voffA);
            PG8_WAIT_L(8); PG8_BAR; PG8_WAIT_L(0); PG8_MMA(0, 0, At, B0); PG8_BAR; PG8_SCHED;
            PG8_LDB(B1, 0, 1); PG8_STAGE(PG8_SB(0, 0), b2, voffB);
            PG8_BAR; PG8_WAIT_L(0); PG8_MMA(0, 1, At, B1); PG8_BAR;
            PG8_LDA(At, 0, 1); PG8_STAGE(PG8_SA(0, 0), a2, voffA);
            PG8_BAR; PG8_WAIT_L(0); PG8_MMA(1, 0, At, B0); PG8_BAR; PG8_SCHED;
            PG8_STAGE(PG8_SB(0, 1), b2 + hstepB, voffB);
            PG8_WAIT_V(6); PG8_BAR; PG8_MMA(1, 1, At, B1); PG8_BAR;
            PG8_LDB(B0, 1, 0); PG8_SCHED; PG8_LDA(At, 1, 0); PG8_STAGE(PG8_SA(0, 1), a2 + hstepA, voffA);
            PG8_WAIT_L(8); PG8_BAR; PG8_WAIT_L(0); PG8_MMA(0, 0, At, B0); PG8_BAR; PG8_SCHED;
            PG8_LDB(B1, 1, 1); PG8_STAGE(PG8_SB(1, 0), b3, voffB);
            PG8_BAR; PG8_WAIT_L(0); PG8_MMA(0, 1, At, B1); PG8_BAR;
            PG8_LDA(At, 1, 1); PG8_STAGE(PG8_SA(1, 0), a3, voffA);
            PG8_BAR; PG8_WAIT_L(0); PG8_MMA(1, 0, At, B0); PG8_BAR; PG8_SCHED;
            PG8_STAGE(PG8_SB(1, 1), b3 + hstepB, voffB);
            PG8_WAIT_V(6); PG8_BAR; PG8_MMA(1, 1, At, B1); PG8_BAR;
            }
        }
        if constexpr (ALIGN_EPI) { if (wr == 0) PG8_BAR; }
        if constexpr (!Epi::AFTER_DRAIN) { E(acc, cur, wr, wc, fr, fq); S.done(cur); }
        if (!has_next) break;
#pragma unroll
        for (int a = 0; a < 2; ++a)
#pragma unroll
            for (int b = 0; b < 2; ++b)
#pragma unroll
                for (int m = 0; m < 4; ++m)
#pragma unroll
                    for (int n = 0; n < 2; ++n) acc[a][b][m][n] = (f32x4){0.f, 0.f, 0.f, 0.f};
        cur = nxt; cA = nA; cB = nB; ++ui;
        if constexpr (ALIGN_EPI) { if (wr == 1) PG8_BAR; }
    }
    PG8_WAIT_V(0);
    if constexpr (!ALIGN_EPI) { if (wr == 0) PG8_BAR; }
    PG8_BAR;
    if constexpr (Epi::AFTER_DRAIN) { E.fused(acc, cur, wr, wc, fr, fq, lds, wid, lane); S.done(cur); }
#undef PG8_SA
#undef PG8_SB
#undef PG8_STAGE
#undef PG8_LDA
#undef PG8_LDB
#undef PG8_MMA
#undef PG8_WAIT_V
#undef PG8_WAIT_L
#undef PG8_BAR
#undef PG8_SCHED
}
}

using pg8::bf16_t; using pg8::bf16x8; using pg8::f32x4; using pg8::u32x4;
typedef unsigned u32x2 __attribute__((ext_vector_type(2)));
#define LAS __attribute__((address_space(3)))

constexpr int NB = 4, SEQ = 8192, T = NB * SEQ, DM = 1024, FF = 2816;
constexpr float LOG2E = 1.4426950408889634f;
constexpr float QSCALE = 0.125f * LOG2E;
constexpr float EPSN = 1e-6f;
constexpr int WIN_COLS = 4888;
constexpr int NWAVES = 8;
constexpr int LDS_BYTES = 147456;

constexpr size_t MiB = 1u << 20;
constexpr size_t WS_F1UP = 1 * MiB, WS_F1DN = 12 * MiB, WS_F2UP = 18 * MiB, WS_F2DN = 29 * MiB, WS_WIN = 35 * MiB, WS_WGA = 41 * MiB, WS_WGB = 43 * MiB, WS_WVT = 45 * MiB;
constexpr size_t WS_CK1 = 46 * MiB, WS_CV1 = 47 * MiB, WS_CK2 = 48 * MiB, WS_CV2 = 48 * MiB + 256 * 1024, WS_PA = 49 * MiB, WS_PB = 50 * MiB;
constexpr size_t WS_WO = 51 * MiB, WS_PG = 53 * MiB, WS_PP = 55 * MiB, WS_BIASK = 512 * 1024, WS_BIASV = 512 * 1024 + 4096, WS_ROPE = 57 * MiB;
constexpr size_t WS_U = 72 * MiB;
constexpr size_t WS_H = 136 * MiB;
constexpr size_t WS_BIG = 264 * MiB;
constexpr size_t WS_Q = WS_BIG, WS_CB = WS_BIG + 32 * MiB, WS_KCR = WS_BIG + 128 * MiB, WS_VCR = WS_BIG + 136 * MiB, WS_KS = WS_BIG + 144 * MiB, WS_KW = WS_BIG + 152 * MiB, WS_VT = WS_BIG + 160 * MiB;
constexpr size_t WS_TMP = WS_BIG, WS_PBF = 56 * MiB;
constexpr size_t WS_SUMSQ = 65536;
constexpr size_t WS_SGA = WS_BIG, WS_SGB = WS_BIG + 64 * MiB;
constexpr size_t WS_TAIL = 440 * MiB;
constexpr size_t WS_GATES = WS_TAIL, WS_HCK = WS_TAIL + 3 * MiB, WS_HCV = WS_TAIL + 5 * MiB, WS_KCOMP = WS_TAIL + 7 * MiB, WS_VCOMPT = WS_TAIL + 7 * MiB + 512 * 1024;
constexpr size_t WS_ONSA = WS_TAIL + 8 * MiB, WS_OCONV = WS_TAIL + 40 * MiB, WS_END = 512 * MiB;

__device__ __forceinline__ unsigned cvt_pk_bf16(float lo, float hi) { unsigned r; asm volatile("s_nop 1\n\tv_cvt_pk_bf16_f32 %0, %1, %2" : "=v"(r) : "v"(lo), "v"(hi)); return r; }
__device__ __forceinline__ unsigned cvt_pk_bf16_t(float lo, float hi) { unsigned r; asm volatile("s_nop 1\n\tv_cvt_pk_bf16_f32 %0, %1, %2\n\ts_nop 1" : "=v"(r) : "v"(lo), "v"(hi)); return r; }
__device__ __forceinline__ u32x2 pack4_t(f32x4 a) { u32x2 w; w.x = cvt_pk_bf16_t(a[0], a[1]); w.y = cvt_pk_bf16_t(a[2], a[3]); return w; }
__device__ __forceinline__ u32x4 pack8(f32x4 a, f32x4 b) { u32x4 w; w.x = cvt_pk_bf16(a[0], a[1]); w.y = cvt_pk_bf16(a[2], a[3]); w.z = cvt_pk_bf16(b[0], b[1]); w.w = cvt_pk_bf16(b[2], b[3]); return w; }
__device__ __forceinline__ u32x2 pack4(f32x4 a) { u32x2 w; w.x = cvt_pk_bf16(a[0], a[1]); w.y = cvt_pk_bf16(a[2], a[3]); return w; }
__device__ __forceinline__ float bf_lo(unsigned w) { return __uint_as_float(w << 16); }
__device__ __forceinline__ float bf_hi(unsigned w) { return __uint_as_float(w & 0xffff0000u); }
__device__ __forceinline__ void unpack8(u32x4 w, f32x4& a, f32x4& b) { a[0] = bf_lo(w.x); a[1] = bf_hi(w.x); a[2] = bf_lo(w.y); a[3] = bf_hi(w.y); b[0] = bf_lo(w.z); b[1] = bf_hi(w.z); b[2] = bf_lo(w.w); b[3] = bf_hi(w.w); }
__device__ __forceinline__ float fsigmoid(float x) { return __builtin_amdgcn_rcpf(1.0f + __builtin_amdgcn_exp2f(-x * LOG2E)); }
__device__ __forceinline__ f32x4 sig4(f32x4 v) { f32x4 r; r[0] = fsigmoid(v[0]); r[1] = fsigmoid(v[1]); r[2] = fsigmoid(v[2]); r[3] = fsigmoid(v[3]); return r; }
__device__ __forceinline__ float gelu_tanh(float x) { const float z = 1.5957691216057308f * (x + 0.044715f * x * x * x); return x * fsigmoid(z); }

enum { K_SWIGLU = 0, K_RESID, K_WIN, K_VT, K_GELU, K_KC, K_VCT, K_PROJA, K_PROJB, K_ST32, K_SIG, K_PLE };
struct Job { const bf16_t* A; const bf16_t* Bt; int M, N, K, lda, kind, rot; void* p0; void* p1; void* p2; float scale; const float* rowss; float* ssout; };
struct WinPtrs { unsigned char* ws; bf16_t* sg; };

struct EpiSwitch {
    static constexpr bool PERM = true, AFTER_DRAIN = false;
    Job J; WinPtrs W;
    template <class F> __device__ __forceinline__ void loop(const f32x4 (&acc)[2][2][4][2], const pg8::Unit& u, int wr, int wc, int fr, int fq, const F& f) const {
        const int row0 = u.pm * 256 + wr * 64 + fr, col0 = u.pn * 256 + wc * 32 + 8 * fq;
#pragma unroll
        for (int ai = 0; ai < 2; ++ai)
#pragma unroll
            for (int m = 0; m < 4; ++m)
#pragma unroll
                for (int bj = 0; bj < 2; ++bj) f(row0 + ai * 128 + m * 16, col0 + bj * 128, acc[ai][bj][m][0], acc[ai][bj][m][1]);
    }
    template <class F> __device__ __forceinline__ void loop_rs(const f32x4 (&acc)[2][2][4][2], const pg8::Unit& u, int wr, int wc, int fr, int fq, const float* rowss, const F& f) const {
        const int row0 = u.pm * 256 + wr * 64 + fr, col0 = u.pn * 256 + wc * 32 + 8 * fq;
#pragma unroll
        for (int ai = 0; ai < 2; ++ai)
#pragma unroll
            for (int m = 0; m < 4; ++m) { const int row = row0 + ai * 128 + m * 16; const float rs = __builtin_amdgcn_rsqf(rowss[row] * (1.f / DM) + EPSN);
#pragma unroll
                for (int bj = 0; bj < 2; ++bj) f(row, col0 + bj * 128, acc[ai][bj][m][0] * rs, acc[ai][bj][m][1] * rs); }
    }
    __device__ __forceinline__ void operator()(const f32x4 (&acc)[2][2][4][2], const pg8::Unit& u, int wr, int wc, int fr, int fq) const {
        asm volatile("s_nop 7\n\ts_nop 7\n\ts_nop 7" ::: "memory");
#ifndef EPI_MASK
#define EPI_MASK 0xffff
#endif
#define EPI_ON(k) ((EPI_MASK >> (k)) & 1)
        switch (J.kind) {
        case K_SWIGLU: if (EPI_ON(K_SWIGLU)) { bf16_t* hid = (bf16_t*)J.p0; const float* rowss = J.rowss;
            const int row0 = u.pm * 256 + wr * 64 + fr, hcol = u.pn * 128 + wc * 16 + 4 * (fq & ~1) + 64 * (fq & 1);
#pragma unroll
            for (int ai = 0; ai < 2; ++ai)
#pragma unroll
                for (int m = 0; m < 4; ++m) { const int row = row0 + ai * 128 + m * 16; const float rs = rowss ? __builtin_amdgcn_rsqf(rowss[row] * (1.f / DM) + EPSN) : 1.0f;
                    u32x2 pk[2];
#pragma unroll
                    for (int bj = 0; bj < 2; ++bj) { f32x4 h;
#pragma unroll
                        for (int i = 0; i < 4; ++i) { const float g = acc[ai][bj][m][0][i] * rs, up = acc[ai][bj][m][1][i] * rs; h[i] = g * fsigmoid(g) * up; }
                        pk[bj] = pack4_t(h); }
                    const u32x2 sx = __builtin_amdgcn_permlane16_swap(pk[0].x, pk[1].x, false, false), sy = __builtin_amdgcn_permlane16_swap(pk[0].y, pk[1].y, false, false);
                    const u32x4 o = {sx.x, sy.x, sx.y, sy.y};
                    *(u32x4*)(hid + (size_t)row * FF + hcol) = o; } } break;
        case K_RESID: if (EPI_ON(K_RESID)) { const float* base = (const float*)J.p0; float* out = (float*)J.p1; bf16_t* hb = (bf16_t*)J.p2; float* ssout = J.ssout; const float sc = J.scale;
            const int row0 = u.pm * 256 + wr * 64 + fr, col0 = u.pn * 256 + wc * 32 + 8 * fq;
#pragma unroll
            for (int ai = 0; ai < 2; ++ai)
#pragma unroll
                for (int m = 0; m < 4; ++m) { const int row = row0 + ai * 128 + m * 16; float ss = 0.f;
#pragma unroll
                    for (int bj = 0; bj < 2; ++bj) { const size_t o = (size_t)row * DM + col0 + bj * 128;
                        const f32x4 h0 = *(const f32x4*)(base + o) + acc[ai][bj][m][0] * sc, h1 = *(const f32x4*)(base + o + 4) + acc[ai][bj][m][1] * sc;
                        *(f32x4*)(out + o) = h0; *(f32x4*)(out + o + 4) = h1; *(u32x4*)(hb + o) = pack8(h0, h1);
                        ss += (h0[0] * h0[0] + h0[1] * h0[1]) + (h0[2] * h0[2] + h0[3] * h0[3]) + (h1[0] * h1[0] + h1[1] * h1[1]) + (h1[2] * h1[2] + h1[3] * h1[3]); }
                    ss += __shfl_xor(ss, 16); ss += __shfl_xor(ss, 32);
                    if (fq == 0) atomicAdd(ssout + row, ss); } } break;
        case K_WIN: if (EPI_ON(K_WIN)) {
            unsigned char* const wsb = W.ws;
            bf16_t* const Wq = (bf16_t*)(wsb + WS_Q); bf16_t* const Wvcr = (bf16_t*)(wsb + WS_VCR); bf16_t* const Wcb = (bf16_t*)(wsb + WS_CB); float* const Wgates = (float*)(wsb + WS_GATES); const float* const Wrope = (const float*)(wsb + WS_ROPE);
            loop_rs(acc, u, wr, wc, fr, fq, J.rowss, [=](int row, int col, f32x4 v0, f32x4 v1) {
                const int b = row >> 13, t = row & 8191;
                if (col < 1024) {
                    if (col >= 640 && col < 768) { const int cc = col - 640, g = cc >> 6, d0 = cc & 63;
                        *(u32x4*)(Wvcr + ((size_t)((b * 2 + g) * SEQ + t)) * 64 + d0) = pack8(v0, v1);
                    } else {
                        const int q8 = (col & 63) >> 3;
                        const f32x4 r0 = *(const f32x4*)(Wrope + (size_t)row * 64 + 8 * q8), r1 = *(const f32x4*)(Wrope + (size_t)row * 64 + 8 * q8 + 4);
                        const float c[4] = {r0[0], r0[2], r1[0], r1[2]}, s[4] = {r0[1], r0[3], r1[1], r1[3]};
                        float sc = 1.f; bf16_t* dst;
                        if (col < 512) { dst = Wq + (size_t)row * 512 + (col & ~63) + 4 * q8; sc = QSCALE; }
                        else { const size_t boff = col < 640 ? WS_KCR : (col < 896 ? WS_KS : WS_KW); bf16_t* bp = (bf16_t*)(wsb + boff); const int g = (col >> 6) & 1; dst = bp + ((size_t)((b * 2 + g) * SEQ + t)) * 64 + 4 * q8; }
                        f32x4 o1, o2;
#pragma unroll
                        for (int i = 0; i < 4; ++i) { o1[i] = (v0[i] * c[i] - v1[i] * s[i]) * sc; o2[i] = (v1[i] * c[i] + v0[i] * s[i]) * sc; }
                        *(u32x2*)dst = pack4(o1); *(u32x2*)(dst + 32) = pack4(o2);
                    }
                } else if (col < 2560) { const int cc = col - 1024, which = cc >> 9, c = cc & 511;
                    *(u32x4*)(Wcb + (size_t)which * T * 512 + (size_t)row * 512 + c) = pack8(v0, v1);
                } else { const int cc = col - 2560;
                    if (cc < 24) { float* gp = Wgates + (size_t)row * 24 + cc; *(f32x4*)gp = sig4(v0); *(f32x4*)(gp + 4) = sig4(v1); }
                } }); } break;
        case K_VT: if (EPI_ON(K_VT)) { bf16_t* vt = (bf16_t*)J.p0;
            const float* css = J.rowss;
            loop(acc, u, wr, wc, fr, fq, [=](int row, int col, f32x4 v0, f32x4 v1) { const f32x4 s0 = *(const f32x4*)(css + col), s1 = *(const f32x4*)(css + col + 4);
#pragma unroll
                for (int i = 0; i < 4; ++i) { v0[i] *= __builtin_amdgcn_rsqf(s0[i] * (1.f / DM) + EPSN); v1[i] *= __builtin_amdgcn_rsqf(s1[i] * (1.f / DM) + EPSN); }
                *(u32x4*)(vt + (size_t)row * T + col) = pack8(v0, v1); }); } break;
        case K_GELU: if (EPI_ON(K_GELU)) { bf16_t* out = (bf16_t*)J.p0; const float* bias = (const float*)J.p1;
            loop(acc, u, wr, wc, fr, fq, [=](int row, int col, f32x4 v0, f32x4 v1) { const f32x4 b0 = *(const f32x4*)(bias + col), b1 = *(const f32x4*)(bias + col + 4); f32x4 a, c;
#pragma unroll
                for (int i = 0; i < 4; ++i) { a[i] = gelu_tanh(v0[i] + b0[i]); c[i] = gelu_tanh(v1[i] + b1[i]); }
                *(u32x4*)(out + (size_t)row * 256 + col) = pack8(a, c); }); } break;
        case K_KC: if (EPI_ON(K_KC)) { bf16_t* kc = (bf16_t*)J.p0;
            loop(acc, u, wr, wc, fr, fq, [=](int row, int col, f32x4 v0, f32x4 v1) { if (col < 64) *(u32x4*)(kc + (size_t)row * 64 + col) = pack8(v0, v1); }); } break;
        case K_VCT: if (EPI_ON(K_VCT)) { bf16_t* vct = (bf16_t*)J.p0;
            loop(acc, u, wr, wc, fr, fq, [=](int row, int col, f32x4 v0, f32x4 v1) { if (row < 64) *(u32x4*)(vct + (size_t)row * 4096 + col) = pack8(v0, v1); }); } break;
        case K_PROJA: if (EPI_ON(K_PROJA)) { bf16_t* sg = (bf16_t*)J.p0;
            loop(acc, u, wr, wc, fr, fq, [=](int row, int col, f32x4 v0, f32x4 v1) { const size_t o = (size_t)row * DM + col; f32x4 s0, s1; unpack8(*(const u32x4*)(sg + o), s0, s1);
                *(u32x4*)(sg + o) = pack8(s0 * v0, s1 * v1); }); } break;
        case K_PROJB: if (EPI_ON(K_PROJB)) { bf16_t* sg = (bf16_t*)J.p0; const bf16_t* tmp = (const bf16_t*)J.p1;
            loop(acc, u, wr, wc, fr, fq, [=](int row, int col, f32x4 v0, f32x4 v1) { const size_t o = (size_t)row * DM + col; f32x4 s0, s1, t0, t1; unpack8(*(const u32x4*)(sg + o), s0, s1); unpack8(*(const u32x4*)(tmp + o), t0, t1);
#ifdef X3_GATE_PLUS_HALF
                s0 = s0 + 0.5f; s1 = s1 + 0.5f;
#endif
                *(u32x4*)(sg + o) = pack8(t0 + s0 * v0, t1 + s1 * v1); }); } break;
        case K_SIG: if (EPI_ON(K_SIG)) { bf16_t* sg = (bf16_t*)J.p0;
            loop_rs(acc, u, wr, wc, fr, fq, J.rowss, [=](int row, int col, f32x4 v0, f32x4 v1) {
#ifdef X4_SIG_CONST
                const f32x4 hf = {0.5f, 0.5f, 0.5f, 0.5f}; *(u32x4*)(sg + (size_t)row * DM + col) = pack8(hf + v0 * 0.f, hf + v1 * 0.f);
#else
#ifdef X6_SCALE
                *(u32x4*)(sg + (size_t)row * DM + col) = pack8(sig4(v0 * X6_SCALE), sig4(v1 * X6_SCALE));
#else
                *(u32x4*)(sg + (size_t)row * DM + col) = pack8(sig4(v0), sig4(v1));
#endif
#endif
                }); } break;
        case K_ST32: if (EPI_ON(K_ST32)) { bf16_t* tmp = (bf16_t*)J.p0;
            loop(acc, u, wr, wc, fr, fq, [=](int row, int col, f32x4 v0, f32x4 v1) { *(u32x4*)(tmp + (size_t)row * DM + col) = pack8(v0, v1); }); } break;
        default: if (EPI_ON(K_PLE)) { float* H = (float*)J.p0; const bf16_t* tmp = (const bf16_t*)J.p1;
            loop_rs(acc, u, wr, wc, fr, fq, J.rowss, [=](int row, int col, f32x4 v0, f32x4 v1) { const size_t o = (size_t)row * DM + col;
                f32x4 t0, t1; unpack8(*(const u32x4*)(tmp + o), t0, t1); const f32x4 h0 = *(const f32x4*)(H + o), h1 = *(const f32x4*)(H + o + 4);
                *(f32x4*)(H + o) = h0 + sig4(v0) * t0; *(f32x4*)(H + o + 4) = h1 + sig4(v1) * t1; }); } break;
        }
#if EPI_DRAIN
        asm volatile("s_waitcnt vmcnt(0)" ::: "memory");
#endif
    }
};

__device__ __forceinline__ float wave_sum(float v) {
#pragma unroll
    for (int o = 1; o < 64; o <<= 1) v += __shfl_xor(v, o);
    return v;
}
enum { PK_ID = 0, PK_SWIGLU, PK_WIN, PK_VT, PK_PAD64, PK_GA, PK_GB };
__device__ __forceinline__ int rope_perm(int j) { const int head = j >> 6, jj = j & 63, q8 = jj >> 3, w = jj & 7; return head * 64 + (w < 4 ? 4 * q8 + w : 32 + 4 * q8 + (w - 4)); }
__device__ __forceinline__ int src_col(int pk, int p, int& which) {
    which = 0;
    switch (pk) {
    case PK_ID: return p;
    case PK_SWIGLU: { const int grp = p >> 3, w = p & 7; which = (w >= 4); return grp * 4 + (w & 3); }
    case PK_WIN: {
        if (p < 512) return rope_perm(p);
        if (p < 640) return 512 + rope_perm(p - 512);
        if (p < 768) return p;
        if (p < 896) return 768 + rope_perm(p - 768);
        if (p < 1024) return 1024 + rope_perm(p - 896);
        if (p < 2560) return 1304 + (p - 1024);
        return (p - 2560) < 24 ? 1280 + (p - 2560) : -1; }
    case PK_VT: return p < 128 ? 896 + p : 1152 + (p - 128);
    case PK_GA: return 2840 + p;
    case PK_GB: return 3864 + p;
    default: return p < 64 ? p : -1;
    }
}
__device__ __forceinline__ unsigned f2bf(float f) { unsigned u = __builtin_bit_cast(unsigned, f); return (u + 0x7fffu + ((u >> 16) & 1u)) >> 16; }
__device__ __forceinline__ unsigned pk2(float lo, float hi) { return f2bf(lo) | (f2bf(hi) << 16); }
__device__ __forceinline__ void transpose_item(const float* W0, const float* W1, const float* gain, int K, int N, int pk, bf16_t* WT, LAS float* scr, int item, int nblk, int lane) {
    const int kb = item / nblk, nb = item % nblk, k0 = 64 * kb, p0 = 64 * nb;
    const int cg = lane & 15;
    int which; const int sc = src_col(pk, p0 + 4 * cg, which);
    const float* W = which ? W1 : W0;
    f32x4 v[16];
#pragma unroll
    for (int i = 0; i < 16; ++i) { const int kk = 4 * i + (lane >> 4);
        v[i] = sc >= 0 ? *(const f32x4*)(W + (size_t)(k0 + kk) * N + sc) * (gain ? gain[k0 + kk] : 1.0f) : (f32x4){0.f, 0.f, 0.f, 0.f}; }
#pragma unroll
    for (int i = 0; i < 16; ++i) { const int kk = 4 * i + (lane >> 4); LAS float* d = scr + kk * 65 + 4 * cg; d[0] = v[i][0]; d[1] = v[i][1]; d[2] = v[i][2]; d[3] = v[i][3]; }
    asm volatile("s_waitcnt lgkmcnt(0)" ::: "memory");
    const int c = lane & 7;
#pragma unroll
    for (int j = 0; j < 8; ++j) { const int n = (lane >> 3) + 8 * j; const LAS float* s = scr + (8 * c) * 65 + n;
        u32x4 o; o.x = pk2(s[0 * 65], s[1 * 65]); o.y = pk2(s[2 * 65], s[3 * 65]); o.z = pk2(s[4 * 65], s[5 * 65]); o.w = pk2(s[6 * 65], s[7 * 65]);
        *(u32x4*)(WT + (size_t)(p0 + n) * K + k0 + 8 * c) = o; }
    asm volatile("s_waitcnt lgkmcnt(0)" ::: "memory");
}
template <bool OUT32> __device__ __forceinline__ void norm_row(const float* xrow, const float* gain, void* orow, int lane) {
    const f32x4* xr = (const f32x4*)xrow + lane; const f32x4* gr = (const f32x4*)gain + lane;
    f32x4 v[4]; float s = 0.f;
#pragma unroll
    for (int j = 0; j < 4; ++j) { v[j] = xr[64 * j]; s += (v[j].x * v[j].x + v[j].y * v[j].y) + (v[j].z * v[j].z + v[j].w * v[j].w); }
    const float r = 1.0f / sqrtf(wave_sum(s) * (1.f / DM) + EPSN);
#pragma unroll
    for (int j = 0; j < 4; ++j) { const f32x4 o = v[j] * r * gr[64 * j];
        if (OUT32) ((f32x4*)orow)[lane + 64 * j] = o; else ((u32x2*)orow)[lane + 64 * j] = pack4(o); }
}

template <bool OUT32, int NR> __device__ __forceinline__ void norm_rows_n(const float* xbase, const float* gain, void* obase, int row0, int rstride, int lane) {
    f32x4 v[NR][4];
#pragma unroll
    for (int r = 0; r < NR; ++r) { const f32x4* xr = (const f32x4*)(xbase + (size_t)(row0 + r * rstride) * DM) + lane;
#pragma unroll
        for (int j = 0; j < 4; ++j) v[r][j] = xr[64 * j]; }
    const f32x4* gr = (const f32x4*)gain + lane; f32x4 gv[4];
#pragma unroll
    for (int j = 0; j < 4; ++j) gv[j] = gr[64 * j];
#pragma unroll
    for (int r = 0; r < NR; ++r) { float s = 0.f;
#pragma unroll
        for (int j = 0; j < 4; ++j) s += (v[r][j].x * v[r][j].x + v[r][j].y * v[r][j].y) + (v[r][j].z * v[r][j].z + v[r][j].w * v[r][j].w);
        const float rs = 1.0f / sqrtf(wave_sum(s) * (1.f / DM) + EPSN);
#pragma unroll
        for (int j = 0; j < 4; ++j) { const f32x4 o = v[r][j] * rs * gv[j];
            if (OUT32) ((f32x4*)((float*)obase + (size_t)(row0 + r * rstride) * DM))[lane + 64 * j] = o; else ((u32x2*)((bf16_t*)obase + (size_t)(row0 + r * rstride) * DM))[lane + 64 * j] = pack4(o); } }
}

__device__ __forceinline__ float rows_max(float v) {
    u32x2 r = __builtin_amdgcn_permlane16_swap(__float_as_uint(v), __float_as_uint(v), false, false); v = fmaxf(__uint_as_float(r.x), __uint_as_float(r.y));
    r = __builtin_amdgcn_permlane32_swap(__float_as_uint(v), __float_as_uint(v), false, false); return fmaxf(__uint_as_float(r.x), __uint_as_float(r.y));
}
__device__ __forceinline__ unsigned wave_umax(unsigned v) {
    unsigned t;
    t = (unsigned)__builtin_amdgcn_mov_dpp((int)v, 0xB1, 0xF, 0xF, true); v = t > v ? t : v;
    t = (unsigned)__builtin_amdgcn_mov_dpp((int)v, 0x4E, 0xF, 0xF, true); v = t > v ? t : v;
    t = (unsigned)__builtin_amdgcn_mov_dpp((int)v, 0x141, 0xF, 0xF, true); v = t > v ? t : v;
    t = (unsigned)__builtin_amdgcn_mov_dpp((int)v, 0x140, 0xF, 0xF, true); v = t > v ? t : v;
    u32x2 r = __builtin_amdgcn_permlane16_swap(v, v, false, false); v = r.x > r.y ? r.x : r.y;
    r = __builtin_amdgcn_permlane32_swap(v, v, false, false); return r.x > r.y ? r.x : r.y;
}
__device__ __forceinline__ float rows_sum(float v) {
    u32x2 r = __builtin_amdgcn_permlane16_swap(__float_as_uint(v), __float_as_uint(v), false, false); v = __uint_as_float(r.x) + __uint_as_float(r.y);
    r = __builtin_amdgcn_permlane32_swap(__float_as_uint(v), __float_as_uint(v), false, false); return __uint_as_float(r.x) + __uint_as_float(r.y);
}
constexpr int A_KB = 0, A_VB = 18432, A_IMP = 36864, A_SEL = 104448;
struct AttnP { const bf16_t *q, *kcomp, *vcompT, *ks, *kw, *VT; const float* gates; float* scratch; float* scratch2; bf16_t* onsa; };

template <int MODE>
__device__ __forceinline__ void attn_tile(const LAS unsigned char* Ks, const LAS unsigned char* Vs, const bf16x8 (&qf)[4][2], f32x4 (&O)[4][4], float (&m)[4], float (&l)[4], const float (&invl)[4],
                                          int mmode  , bool track, bool lane_valid, int kbase, int kmax, int kmin, LAS float* imp_row, float& carry, int fr, int fq, int lane) {
    const bool masked = (mmode == 2);
#pragma unroll 1
    for (int ks = 0; ks < 2; ++ks) {
        bf16x8 kf[2][2];
#pragma unroll
        for (int sub = 0; sub < 2; ++sub)
#pragma unroll
            for (int ch = 0; ch < 2; ++ch) kf[sub][ch] = *(const LAS bf16x8*)(Ks + (ks * 32 + sub * 16 + fr) * 144 + ch * 64 + fq * 16);
        f32x4 s[4][2];
#pragma unroll
        for (int hh = 0; hh < 4; ++hh)
#pragma unroll
            for (int sub = 0; sub < 2; ++sub) { f32x4 a = {0.f, 0.f, 0.f, 0.f};
                a = __builtin_amdgcn_mfma_f32_16x16x32_bf16(kf[sub][0], qf[hh][0], a, 0, 0, 0);
                a = __builtin_amdgcn_mfma_f32_16x16x32_bf16(kf[sub][1], qf[hh][1], a, 0, 0, 0); s[hh][sub] = a; }
        if (masked) {
#pragma unroll
            for (int sub = 0; sub < 2; ++sub)
#pragma unroll
                for (int i = 0; i < 4; ++i) { const int kidx = kbase + ks * 32 + sub * 16 + 4 * fq + i; const bool v = lane_valid && kidx <= kmax && kidx > kmin;
#pragma unroll
                    for (int hh = 0; hh < 4; ++hh) s[hh][sub][i] = v ? s[hh][sub][i] : -1e30f; }
        }
        bf16x8 pf[4];
        float ps[2][4] = {{0.f, 0.f, 0.f, 0.f}, {0.f, 0.f, 0.f, 0.f}};
#pragma unroll
        for (int hh = 0; hh < 4; ++hh) {
            f32x4 p0, p1;
            if (MODE != 2) {
                float mn = m[hh], alpha = 1.0f;
                if (track) {
                    float mx = fmaxf(fmaxf(fmaxf(s[hh][0][0], s[hh][0][1]), fmaxf(s[hh][0][2], s[hh][0][3])), fmaxf(fmaxf(s[hh][1][0], s[hh][1][1]), fmaxf(s[hh][1][2], s[hh][1][3])));
                    mx = rows_max(mx);
                    if (mmode == 1) mx = lane_valid ? mx : -1e30f;
                    mn = fmaxf(m[hh], mx); alpha = __builtin_amdgcn_exp2f(m[hh] - mn);
                    m[hh] = mn;
                }
#pragma unroll
                for (int i = 0; i < 4; ++i) { p0[i] = __builtin_amdgcn_exp2f(s[hh][0][i] - mn); p1[i] = __builtin_amdgcn_exp2f(s[hh][1][i] - mn); }
                if (masked) {
#pragma unroll
                    for (int i = 0; i < 4; ++i) { p0[i] = s[hh][0][i] < -1e29f ? 0.f : p0[i]; p1[i] = s[hh][1][i] < -1e29f ? 0.f : p1[i]; }
                }
                if (mmode == 1) { const f32x4 z = {0.f, 0.f, 0.f, 0.f}; p0 = lane_valid ? p0 : z; p1 = lane_valid ? p1 : z; }
                l[hh] = l[hh] * alpha + ((p0[0] + p0[1]) + (p0[2] + p0[3])) + ((p1[0] + p1[1]) + (p1[2] + p1[3]));
                if (MODE == 1 && track) { if (__builtin_amdgcn_ballot_w64(alpha != 1.0f) != 0ull) {
#pragma unroll
                    for (int dt = 0; dt < 4; ++dt) O[hh][dt] = O[hh][dt] * alpha; } }
            } else {
                const float mh = m[hh], il = invl[hh];
#pragma unroll
                for (int i = 0; i < 4; ++i) { p0[i] = __builtin_amdgcn_exp2f(s[hh][0][i] - mh) * il; p1[i] = __builtin_amdgcn_exp2f(s[hh][1][i] - mh) * il; }
                if (masked) {
#pragma unroll
                    for (int i = 0; i < 4; ++i) { p0[i] = s[hh][0][i] < -1e29f ? 0.f : p0[i]; p1[i] = s[hh][1][i] < -1e29f ? 0.f : p1[i]; }
                }
#pragma unroll
                for (int i = 0; i < 4; ++i) { ps[0][i] += p0[i]; ps[1][i] += p1[i]; }
            }
            if (MODE != 0) { const u32x4 w = pack8(p0, p1); pf[hh] = __builtin_bit_cast(bf16x8, w); }
        }
        if (MODE == 2) {
            const float a0 = ps[0][0] + ps[0][1] + ps[0][2] + 0.5f * ps[0][3], b0 = 0.5f * ps[0][3];
            const float a1 = ps[1][0] + ps[1][1] + ps[1][2] + 0.5f * ps[1][3], b1 = 0.5f * ps[1][3];
            const int src = (lane - 16) & 63;
            const float x0 = __shfl(b0, src), x1 = __shfl(b1, src);
            const int sa = (kbase + ks * 32) / 4 + fq;
            imp_row[sa] = a0 + (fq > 0 ? x0 : carry);
            imp_row[sa + 4] = a1 + (fq > 0 ? x1 : x0);
            carry = x1;
        }
        if (MODE != 0) {
#pragma unroll
            for (int dt = 0; dt < 4; ++dt) {
                const u32x2 v0 = *(const LAS u32x2*)(Vs + (dt * 16 + fr) * 144 + ks * 64 + fq * 8), v1 = *(const LAS u32x2*)(Vs + (dt * 16 + fr) * 144 + ks * 64 + 32 + fq * 8);
                const u32x4 vv = {v0.x, v0.y, v1.x, v1.y}; const bf16x8 vf = __builtin_bit_cast(bf16x8, vv);
#pragma unroll
                for (int hh = 0; hh < 4; ++hh) O[hh][dt] = __builtin_amdgcn_mfma_f32_16x16x32_bf16(vf, pf[hh], O[hh][dt], 0, 0, 0);
            }
        }
    }
}

template <int BR>
__device__ __forceinline__ void run_branch(LAS unsigned char* lds, const bf16_t* Kg, const bf16_t* Vg, int ldv, int jlo, int jhi, const bf16x8 (&qf)[4][2], f32x4 (&O)[4][4], float (&m)[4], float (&l)[4],
                                           const float (&invl)[4], int tid, int w, int lane, int fr, int fq, int qlo, int tq, int blkq, unsigned long long sel_lo, unsigned long long sel_hi) {
    constexpr int MODE = (BR == 0) ? 0 : (BR == 1 ? 2 : 1);
    const int lrow = tid >> 3, lch = tid & 7;
    u32x4 kr, vr;
#define A_GLOAD(j) do { kr = *(const u32x4*)(Kg + (size_t)(64 * (j) + lrow) * 64 + lch * 8); vr = *(const u32x4*)(Vg + (size_t)lrow * ldv + 64 * (j) + lch * 8); } while (0)
#define A_LSTORE(buf) do { *(LAS u32x4*)(lds + A_KB + (buf) * 9216 + lrow * 144 + lch * 16) = kr; *(LAS u32x4*)(lds + A_VB + (buf) * 9216 + lrow * 144 + lch * 16) = vr; } while (0)
    A_GLOAD(jlo); A_LSTORE(0); __syncthreads();
    float carry = 0.f;
    LAS float* imp_row = (LAS float*)(lds + A_IMP) + (w * 16 + fr) * 132;
    for (int j = jlo; j <= jhi; ++j) {
        const int cur = (j - jlo) & 1;
        if (j < jhi) A_GLOAD(j + 1);
        bool skip = false, masked = false, lane_valid = true; int kmax = 0x7fffffff, kmin = -1;
        if (BR <= 1) { const int lim_lo = (qlo - 31) >> 4, lim_hi = (qlo + 15 - 31) >> 4; kmax = (tq - 31) >> 4; masked = (64 * j + 63 > lim_lo); skip = (BR == 0) && (64 * j > lim_hi); }
        if (BR == 2) { lane_valid = (((j < 64 ? sel_lo : sel_hi) >> (j & 63)) & 1ull) != 0ull; const unsigned long long bal = __builtin_amdgcn_ballot_w64(lane_valid);
            skip = (j > blkq) || (bal == 0ull); masked = (j == blkq) || (bal != ~0ull); kmax = (j == blkq) ? tq : 0x7fffffff; }
        if (BR == 3) { skip = (64 * j > qlo + 15) || (64 * j + 63 <= qlo - 512); masked = (64 * j + 63 > qlo) || (64 * j <= qlo + 15 - 512); kmax = tq; kmin = tq - 512; }
        int mmode = masked ? 2 : 0;
        const bool track = (MODE != 1) || (__builtin_amdgcn_ballot_w64(m[0] < -1e29f) != 0ull);
        if (BR == 2) mmode = (j == blkq) ? 2 : (masked ? 1 : 0);
        if (!skip) attn_tile<MODE>(lds + A_KB + cur * 9216, lds + A_VB + cur * 9216, qf, O, m, l, invl, mmode, track, lane_valid, 64 * j, kmax, kmin, imp_row, carry, fr, fq, lane);
        if (j < jhi) A_LSTORE(cur ^ 1);
        __syncthreads();
    }
#undef A_GLOAD
#undef A_LSTORE
}


__device__ __forceinline__ void run_branch_sel(LAS unsigned char* lds, const bf16_t* Kg, const bf16_t* Vg, int ldv, int jhi, const bf16_t* qbase  ,
                                               const float* gbase  , bf16_t* obase  ,
                                               int tid, int w, int lane, int fr, int fq, int qlo, int blkq) {
    const int lrow = tid >> 3, lch = tid & 7;
    const int ql = fr >> 2, hl = fr & 3;
    bf16x8 qf[4][2]; f32x4 O[4][4]; float m[4], l[4];
#pragma unroll
    for (int gi = 0; gi < 4; ++gi) { m[gi] = -1e30f; l[gi] = 0.f;
#pragma unroll
        for (int ch = 0; ch < 2; ++ch) qf[gi][ch] = *(const bf16x8*)(qbase + (size_t)(gi * 4 + ql) * 512 + hl * 64 + ch * 32 + fq * 8);
#pragma unroll
        for (int dt = 0; dt < 4; ++dt) O[gi][dt] = (f32x4){0.f, 0.f, 0.f, 0.f}; }
    const LAS unsigned* selw = (const LAS unsigned*)(lds + A_SEL) + (w * 16 + ql) * 4;
    u32x4 kr, vr;
#define S_GLOAD(j) do { kr = *(const u32x4*)(Kg + (size_t)(64 * (j) + lrow) * 64 + lch * 8); vr = *(const u32x4*)(Vg + (size_t)lrow * ldv + 64 * (j) + lch * 8); } while (0)
#define S_LSTORE(buf) do { *(LAS u32x4*)(lds + A_KB + (buf) * 9216 + lrow * 144 + lch * 16) = kr; *(LAS u32x4*)(lds + A_VB + (buf) * 9216 + lrow * 144 + lch * 16) = vr; } while (0)
    S_GLOAD(0); S_LSTORE(0); __syncthreads();
    for (int j = 0; j <= jhi; ++j) {
        const int cur = j & 1;
        if (j < jhi) S_GLOAD(j + 1);
        if (j <= blkq) {
            const LAS unsigned char* Ks = lds + A_KB + cur * 9216; const LAS unsigned char* Vs = lds + A_VB + cur * 9216;
            bool lv[4]; unsigned long long bal[4]; bool anyg = false;
#pragma unroll
            for (int gi = 0; gi < 4; ++gi) { lv[gi] = ((selw[gi * 16 + (j >> 5)] >> (j & 31)) & 1u) != 0u; bal[gi] = __builtin_amdgcn_ballot_w64(lv[gi]); anyg = anyg || (bal[gi] != 0ull); }
            if (anyg) {
#pragma unroll
                for (int ks = 0; ks < 2; ++ks) {
                    bf16x8 kf[2][2], vf[4];
#pragma unroll
                    for (int sub = 0; sub < 2; ++sub)
#pragma unroll
                        for (int ch = 0; ch < 2; ++ch) kf[sub][ch] = *(const LAS bf16x8*)(Ks + (ks * 32 + sub * 16 + fr) * 144 + ch * 64 + fq * 16);
#pragma unroll
                    for (int dt = 0; dt < 4; ++dt) { const u32x2 v0 = *(const LAS u32x2*)(Vs + (dt * 16 + fr) * 144 + ks * 64 + fq * 8), v1 = *(const LAS u32x2*)(Vs + (dt * 16 + fr) * 144 + ks * 64 + 32 + fq * 8);
                        const u32x4 vv = {v0.x, v0.y, v1.x, v1.y}; vf[dt] = __builtin_bit_cast(bf16x8, vv); }
#pragma unroll
                    for (int gi = 0; gi < 4; ++gi) {
                        if (bal[gi] != 0ull) {
                            f32x4 s0 = {0.f, 0.f, 0.f, 0.f}, s1 = {0.f, 0.f, 0.f, 0.f};
                            s0 = __builtin_amdgcn_mfma_f32_16x16x32_bf16(kf[0][0], qf[gi][0], s0, 0, 0, 0); s0 = __builtin_amdgcn_mfma_f32_16x16x32_bf16(kf[0][1], qf[gi][1], s0, 0, 0, 0);
                            s1 = __builtin_amdgcn_mfma_f32_16x16x32_bf16(kf[1][0], qf[gi][0], s1, 0, 0, 0); s1 = __builtin_amdgcn_mfma_f32_16x16x32_bf16(kf[1][1], qf[gi][1], s1, 0, 0, 0);
                            const bool alllv = (bal[gi] == ~0ull);
                            if (j == blkq) {
                                const int tqg = qlo + gi * 4 + ql;
#pragma unroll
                                for (int i = 0; i < 4; ++i) { const int k0 = 64 * j + ks * 32 + 4 * fq + i; s0[i] = (k0 <= tqg) ? s0[i] : -1e30f; s1[i] = (k0 + 16 <= tqg) ? s1[i] : -1e30f; }
                            }
                            float mn = m[gi], alpha = 1.0f;
                            const bool track = __builtin_amdgcn_ballot_w64(m[gi] < -1e29f) != 0ull;
                            if (track) {
                                float mx = fmaxf(fmaxf(fmaxf(s0[0], s0[1]), fmaxf(s0[2], s0[3])), fmaxf(fmaxf(s1[0], s1[1]), fmaxf(s1[2], s1[3])));
                                mx = rows_max(mx); mx = lv[gi] ? mx : -1e30f;
                                mn = fmaxf(m[gi], mx); alpha = __builtin_amdgcn_exp2f(m[gi] - mn); m[gi] = mn;
                            }
                            f32x4 p0, p1;
#pragma unroll
                            for (int i = 0; i < 4; ++i) { p0[i] = __builtin_amdgcn_exp2f(s0[i] - mn); p1[i] = __builtin_amdgcn_exp2f(s1[i] - mn); }
                            if (j == blkq) {
#pragma unroll
                                for (int i = 0; i < 4; ++i) { p0[i] = s0[i] < -1e29f ? 0.f : p0[i]; p1[i] = s1[i] < -1e29f ? 0.f : p1[i]; }
                            }
                            if (!alllv) { const f32x4 z = {0.f, 0.f, 0.f, 0.f}; p0 = lv[gi] ? p0 : z; p1 = lv[gi] ? p1 : z; }
                            l[gi] = l[gi] * alpha + ((p0[0] + p0[1]) + (p0[2] + p0[3])) + ((p1[0] + p1[1]) + (p1[2] + p1[3]));
                            if (track) { if (__builtin_amdgcn_ballot_w64(alpha != 1.0f) != 0ull) {
#pragma unroll
                                for (int dt = 0; dt < 4; ++dt) O[gi][dt] = O[gi][dt] * alpha; } }
                            const u32x4 pw = pack8(p0, p1); const bf16x8 pf = __builtin_bit_cast(bf16x8, pw);
#pragma unroll
                            for (int dt = 0; dt < 4; ++dt) O[gi][dt] = __builtin_amdgcn_mfma_f32_16x16x32_bf16(vf[dt], pf, O[gi][dt], 0, 0, 0);
                        }
                    }
                }
            }
        }
        if (j < jhi) S_LSTORE(cur ^ 1);
        __syncthreads();
    }
#undef S_GLOAD
#undef S_LSTORE
#pragma unroll
    for (int gi = 0; gi < 4; ++gi) { const float lt = rows_sum(l[gi]); const float gt = lt > 0.f ? gbase[(size_t)(gi * 4 + ql) * 24 + hl * 3 + 1] / lt : 0.f;
        bf16_t* op = obase + (size_t)(gi * 4 + ql) * 512 + hl * 64 + 4 * fq;
#pragma unroll
        for (int dt = 0; dt < 4; ++dt) *(u32x2*)(op + dt * 16) = pack4(O[gi][dt] * gt); }
}

__device__ __forceinline__ void attn_unit(LAS unsigned char* lds, const AttnP& P, int b, int g, int iu, int tid, int w, int lane) {
    const int fr = lane & 15, fq = lane >> 4;
    const int t0 = iu * 128, qlo = t0 + 16 * w, tq = qlo + fr, blkq = qlo >> 6;
    const size_t rowq = (size_t)b * SEQ + tq;
#define A_STATE() bf16x8 qf[4][2]; f32x4 O[4][4]; float m[4], l[4], invl[4]; \
    _Pragma("unroll") for (int hh = 0; hh < 4; ++hh) _Pragma("unroll") for (int ch = 0; ch < 2; ++ch) qf[hh][ch] = *(const bf16x8*)(P.q + rowq * 512 + (g * 4 + hh) * 64 + ch * 32 + fq * 8)
#define A_RESET() do { _Pragma("unroll") for (int hh = 0; hh < 4; ++hh) { m[hh] = -1e30f; l[hh] = 0.f; invl[hh] = 0.f; _Pragma("unroll") for (int dt = 0; dt < 4; ++dt) O[hh][dt] = (f32x4){0.f, 0.f, 0.f, 0.f}; } } while (0)
#define A_FINL() do { _Pragma("unroll") for (int hh = 0; hh < 4; ++hh) { float lt = rows_sum(l[hh]); invl[hh] = lt > 0.f ? 1.0f / lt : 0.f; } } while (0)
    const int bg = b * 2 + g;
#define A_PTRS() size_t rq_ = rowq; asm volatile("" : "+v"(rq_)); float* scr = P.scratch + rq_ * 512 + g * 256 + 4 * fq; const float* gp = P.gates + rq_ * 24 + g * 12
    { A_STATE();
    {
        const bf16_t* Kc = P.kcomp + (size_t)(bg * 512) * 64; const bf16_t* Vc = P.vcompT + bg * 512;
        const int ntc = (8 * iu + 7 + 63) >> 6;
        A_RESET();
        run_branch<0>(lds, Kc, Vc, 4096, 0, ntc - 1, qf, O, m, l, invl, tid, w, lane, fr, fq, qlo, tq, blkq, 0ull, 0ull);
        A_FINL();
        run_branch<1>(lds, Kc, Vc, 4096, 0, ntc - 1, qf, O, m, l, invl, tid, w, lane, fr, fq, qlo, tq, blkq, 0ull, 0ull);
    }
    {
        LAS float* impw = (LAS float*)(lds + A_IMP) + (w * 16) * 132;
        LAS unsigned* sel = (LAS unsigned*)(lds + A_SEL) + (w * 16) * 4;
        for (int qi = 0; qi < 8; ++qi) {
            unsigned long long loA, hiA = 0ull, loB, hiB = 0ull;
            if (blkq + 1 <= 16) { loA = (2ull << blkq) - 1ull; loB = loA; }
            else {
                loA = 1ull;
                { const int s1 = blkq - 1, s2 = blkq; if (s1 < 64) loA |= 1ull << s1; else hiA |= 1ull << (s1 - 64); if (s2 < 64) loA |= 1ull << s2; else hiA |= 1ull << (s2 - 64); }
                loB = loA; hiB = hiA;
                const float a0 = impw[qi * 132 + lane], a1 = impw[qi * 132 + 64 + lane], b0 = impw[(qi + 8) * 132 + lane], b1 = impw[(qi + 8) * 132 + 64 + lane];
                const bool c0 = (lane >= 1 && lane <= blkq - 2), c1 = (lane + 64 <= blkq - 2);
                unsigned ka0 = c0 ? ((__float_as_uint(a0) & ~127u) | (unsigned)(127 - lane)) : 0u, ka1 = c1 ? ((__float_as_uint(a1) & ~127u) | (unsigned)(63 - lane)) : 0u;
                unsigned kb0 = c0 ? ((__float_as_uint(b0) & ~127u) | (unsigned)(127 - lane)) : 0u, kb1 = c1 ? ((__float_as_uint(b1) & ~127u) | (unsigned)(63 - lane)) : 0u;
                for (int r = 0; r < 13; ++r) {
                    unsigned bestA = ka0 > ka1 ? ka0 : ka1, bestB = kb0 > kb1 ? kb0 : kb1;
                    bestA = wave_umax(bestA); bestB = wave_umax(bestB);
                    bestA = (unsigned)__builtin_amdgcn_readfirstlane((int)bestA); bestB = (unsigned)__builtin_amdgcn_readfirstlane((int)bestB);
                    const int sA = 127 - (int)(bestA & 127u), sB = 127 - (int)(bestB & 127u);
                    if (sA < 64) loA |= 1ull << sA; else hiA |= 1ull << (sA - 64);
                    if (sB < 64) loB |= 1ull << sB; else hiB |= 1ull << (sB - 64);
                    if (ka0 == bestA) ka0 = 0u; if (ka1 == bestA) ka1 = 0u; if (kb0 == bestB) kb0 = 0u; if (kb1 == bestB) kb1 = 0u;
                }
            }
            if (lane == 0) { sel[qi * 4 + 0] = (unsigned)loA; sel[qi * 4 + 1] = (unsigned)(loA >> 32); sel[qi * 4 + 2] = (unsigned)hiA; sel[qi * 4 + 3] = (unsigned)(hiA >> 32);
                             sel[(qi + 8) * 4 + 0] = (unsigned)loB; sel[(qi + 8) * 4 + 1] = (unsigned)(loB >> 32); sel[(qi + 8) * 4 + 2] = (unsigned)hiB; sel[(qi + 8) * 4 + 3] = (unsigned)(hiB >> 32); }
        }
    }
    { A_PTRS();
#pragma unroll
    for (int hh = 0; hh < 4; ++hh) { const float gt = gp[hh * 3 + 0];
#pragma unroll
        for (int dt = 0; dt < 4; ++dt) *(f32x4*)(scr + hh * 64 + dt * 16) = O[hh][dt] * gt; } }
    }
    {
        const bf16_t* Kg = P.ks + (size_t)(bg * SEQ) * 64; const bf16_t* Vg = P.VT + (size_t)(g * 64) * T + (size_t)b * SEQ;
        const size_t r0 = (size_t)b * SEQ + qlo;
        run_branch_sel(lds, Kg, Vg, T, 2 * iu + 1, P.q + r0 * 512 + g * 256, P.gates + r0 * 24 + g * 12, P.onsa + r0 * 512 + g * 256, tid, w, lane, fr, fq, qlo, blkq);
    }
    {
        A_STATE();
        const bf16_t* Kg = P.kw + (size_t)(bg * SEQ) * 64; const bf16_t* Vg = P.VT + (size_t)(128 + g * 64) * T + (size_t)b * SEQ;
        A_RESET();
        const int jlo = 2 * iu - 8 < 0 ? 0 : 2 * iu - 8;
        run_branch<3>(lds, Kg, Vg, T, jlo, 2 * iu + 1, qf, O, m, l, invl, tid, w, lane, fr, fq, qlo, tq, blkq, 0ull, 0ull);
        A_FINL();
        A_PTRS(); bf16_t* op = P.onsa + rq_ * 512 + g * 256 + 4 * fq;
#pragma unroll
        for (int hh = 0; hh < 4; ++hh) { const float gt = gp[hh * 3 + 2] * invl[hh];
#pragma unroll
            for (int dt = 0; dt < 4; ++dt) { const u32x2 pk_ = *(const u32x2*)(op + hh * 64 + dt * 16); const f32x4 sel_ = {bf_lo(pk_.x), bf_hi(pk_.x), bf_lo(pk_.y), bf_hi(pk_.y)};
                const f32x4 r = *(const f32x4*)(scr + hh * 64 + dt * 16) + sel_ + O[hh][dt] * gt; *(u32x2*)(op + hh * 64 + dt * 16) = pack4(r); } }
    }
#undef A_STATE
#undef A_PTRS
#undef A_RESET
#undef A_FINL
}

#define XB_TMO      128
#define XB_XCNT(j)  (256  + 64 * (j))
#define XB_XSUB(j)  (1280 + 64 * (j))
#define XB_XGEN(j)  (2304 + 64 * (j))
#define XB_TOP      3328
#define XB_TOPGEN   3392
#define XCD_BAR_WORDS 3456
#define XB_SPIN_CAP (1u << 18)

__device__ __forceinline__ unsigned xb_ld(unsigned* p)              { return __hip_atomic_load(p, __ATOMIC_RELAXED, __HIP_MEMORY_SCOPE_AGENT); }
__device__ __forceinline__ unsigned xb_add(unsigned* p, unsigned v) { return __hip_atomic_fetch_add(p, v, __ATOMIC_RELAXED, __HIP_MEMORY_SCOPE_AGENT); }
__device__ __forceinline__ unsigned xb_xcc_id() { return (unsigned)__builtin_amdgcn_s_getreg((3 << 11) | 20) & 0xFu; }
#define XB_SPIN(cond, bar) do { unsigned _sp = 0; while (cond) { __builtin_amdgcn_s_sleep(1); \
    if ((++_sp & 255u) == 0u) { if (xb_ld(&(bar)[XB_TMO])) break; if (_sp > XB_SPIN_CAP) { atomicAdd(&(bar)[XB_TMO], 1u); break; } } } } while (0)

struct XcdBarrier {
    unsigned* bar; unsigned x;
    volatile LAS unsigned* st;
};

__device__ __forceinline__ XcdBarrier xcd_barrier_post(unsigned* bar, volatile LAS unsigned* st) {
    XcdBarrier b; b.bar = bar; b.x = xb_xcc_id(); b.st = st;
    if (threadIdx.x == 0) (void)xb_add(&bar[XB_XCNT(b.x)], 1u);
    return b;
}
__device__ __forceinline__ void xcd_barrier_complete(unsigned* bar, unsigned x, unsigned& nloc, unsigned& nx) {
    const unsigned G = gridDim.x * gridDim.y * gridDim.z;
    unsigned sum, cnt, mine, sp = 0u;
    for (;;) {
        sum = 0u; cnt = 0u; mine = 0u;
#pragma unroll
        for (unsigned j = 0; j < 16; ++j) { const unsigned c = xb_ld(&bar[XB_XCNT(j)]); sum += c; cnt += (c > 0u) ? 1u : 0u; mine = (j == x) ? c : mine; }
        if (sum == G) break;
        __builtin_amdgcn_s_sleep(1);
        if ((++sp & 255u) == 0u) { if (xb_ld(&bar[XB_TMO])) break; if (sp > XB_SPIN_CAP) { atomicAdd(&bar[XB_TMO], 1u); break; } }
    }
    nloc = mine > 0u ? mine : 1u; nx = cnt > 0u ? cnt : 1u;
}

__device__ __forceinline__ void xcd_barrier(const XcdBarrier& b) {
    asm volatile("s_waitcnt vmcnt(0)" ::: "memory");
    __syncthreads();
    if (threadIdx.x == 0) {
        unsigned* bar = b.bar;
        __builtin_amdgcn_s_waitcnt(0);
        unsigned nloc = b.st[0], nx = b.st[1];
        if (nloc == 0u) { xcd_barrier_complete(bar, b.x, nloc, nx); b.st[0] = nloc; b.st[1] = nx; }
        const unsigned old = xb_add(&bar[XB_XSUB(b.x)], 1u);
        const unsigned gen = old / nloc;
        if (old + 1u == (gen + 1u) * nloc) {
            __builtin_amdgcn_fence(__ATOMIC_RELEASE, "agent");
            asm volatile("s_waitcnt vmcnt(0)" ::: "memory");
            const unsigned og = xb_add(&bar[XB_TOP], 1u);
            const unsigned tg = og / nx;
            if (og + 1u == (tg + 1u) * nx) xb_add(&bar[XB_TOPGEN], 1u);
            else XB_SPIN(xb_ld(&bar[XB_TOPGEN]) == tg, bar);
            __builtin_amdgcn_fence(__ATOMIC_ACQUIRE, "agent");
            xb_add(&bar[XB_XGEN(b.x)], 1u);
            asm volatile("s_waitcnt vmcnt(0)" ::: "memory");
        } else {
            XB_SPIN(xb_ld(&bar[XB_XGEN(b.x)]) == gen, bar);
            __builtin_amdgcn_fence(__ATOMIC_ACQUIRE, "agent");
            asm volatile("s_waitcnt vmcnt(0)" ::: "memory");
        }
    }
    __syncthreads();
}

struct Args { const void* in[30]; float* out; unsigned char* ws; double invf[32]; int ph_lo, ph_hi; };

enum { PH_PRO = 0, PH_F1UP, PH_F1DN, PH_WIN, PH_WVT, PH_C1K, PH_C2K, PH_C1V, PH_C2V, PH_CONV, PH_PCONV, PH_ATTN, PH_GA, PH_PA, PH_GB, PH_PB, PH_WO, PH_F2UP, PH_F2DN, PH_PP, PH_PG, PH_FNORM, PH_N };
__host__ __device__ inline bool sync_after(int k) { return !(k == PH_WIN || k == PH_C1K || k == PH_C1V || k == PH_C2K || k == PH_C2V || k == PH_CONV || k == PH_GA || k == PH_PA || (k == PH_GB && !(DBG_GATE >= 1 && DBG_GATE <= 4)) || k == PH_PP || k == PH_FNORM); }

__global__ void __launch_bounds__(512, 2) fwd_kernel(Args a) {
    extern __shared__ __attribute__((aligned(16))) unsigned char lds_raw[];
    LAS unsigned char* lds = (LAS unsigned char*)lds_raw;
    const int G = gridDim.x, bid = blockIdx.x, NGW = G * NWAVES;
    unsigned char* ws = a.ws;
    const float* x = (const float*)a.in[0]; const float* pin = (const float*)a.in[1]; const int* positions = (const int*)a.in[2];
    float* H = (float*)(ws + WS_H); bf16_t* U = (bf16_t*)(ws + WS_U); bf16_t* HID = (bf16_t*)(ws + WS_BIG);

#if !SPLIT_LAUNCH
    volatile LAS unsigned* bar_st = (volatile LAS unsigned*)(lds + 139264);
    if (threadIdx.x < 2) bar_st[threadIdx.x] = 0u;
    __syncthreads();
    XcdBarrier xbar = xcd_barrier_post((unsigned*)ws + 1024, bar_st);
#endif
#ifndef REP_PRO_N
#define REP_PRO_N 0
#endif
#ifndef PRO_SKIP_T
#define PRO_SKIP_T 0
#endif
    for (int it_ = a.ph_lo - REP_PRO_N; it_ < a.ph_hi; ++it_) { const int ph = it_ < 0 ? 0 : it_;
        int tid = threadIdx.x; asm volatile("" : "+v"(tid));
        const int lane = tid & 63, wave = __builtin_amdgcn_readfirstlane(tid >> 6), gw = bid * NWAVES + wave;
        Job J; J.A = nullptr; J.Bt = nullptr; J.M = 0; J.N = 0; J.K = 0; J.lda = 0; J.kind = -1; J.rot = 0; J.p0 = nullptr; J.p1 = nullptr; J.p2 = nullptr; J.scale = 1.f;
        switch (ph) {
        case PH_F1UP: J.A = U; J.Bt = (bf16_t*)(ws + WS_F1UP); J.M = T; J.N = 2 * FF; J.K = DM; J.lda = DM; J.kind = K_SWIGLU; J.p0 = HID; break;
        case PH_F1DN: J.A = HID; J.Bt = (bf16_t*)(ws + WS_F1DN); J.M = T; J.N = DM; J.K = FF; J.lda = FF; J.kind = K_RESID; J.p0 = (void*)x; J.p1 = H; J.scale = 0.5f; break;
        case PH_WIN: J.A = U; J.Bt = (bf16_t*)(ws + WS_WIN); J.M = T; J.N = 2816; J.K = DM; J.lda = DM; J.kind = K_WIN; break;
        case PH_WVT: J.A = (bf16_t*)(ws + WS_WVT); J.Bt = U; J.M = 256; J.N = T; J.K = DM; J.lda = DM; J.kind = K_VT; J.rot = 128; J.p0 = ws + WS_VT; break;
        case PH_C1K: J.A = (bf16_t*)(ws + WS_KCR); J.Bt = (bf16_t*)(ws + WS_CK1); J.M = 4096; J.N = 256; J.K = 2048; J.lda = 1024; J.kind = K_GELU; J.p0 = ws + WS_HCK; J.p1 = ws + WS_BIASK; break;
        case PH_C1V: J.A = (bf16_t*)(ws + WS_VCR); J.Bt = (bf16_t*)(ws + WS_CV1); J.M = 4096; J.N = 256; J.K = 2048; J.lda = 1024; J.kind = K_GELU; J.rot = 16; J.p0 = ws + WS_HCV; J.p1 = ws + WS_BIASV; break;
        case PH_C2K: J.A = (bf16_t*)(ws + WS_HCK); J.Bt = (bf16_t*)(ws + WS_CK2); J.M = 4096; J.N = 256; J.K = 256; J.lda = 256; J.kind = K_KC; J.p0 = ws + WS_KCOMP; break;
        case PH_C2V: J.A = (bf16_t*)(ws + WS_CV2); J.Bt = (bf16_t*)(ws + WS_HCV); J.M = 256; J.N = 4096; J.K = 256; J.lda = 256; J.kind = K_VCT; J.rot = 16; J.p0 = ws + WS_VCOMPT; break;
        case PH_GA: J.A = U; J.Bt = (bf16_t*)(ws + WS_WGA); J.M = T; J.N = DM; J.K = DM; J.lda = DM; J.kind = K_SIG; J.p0 = ws + WS_SGA; break;
        case PH_PA: J.A = (bf16_t*)(ws + WS_ONSA); J.Bt = (bf16_t*)(ws + WS_PA); J.M = T; J.N = DM; J.K = 512; J.lda = 512; J.kind = K_PROJA; J.p0 = ws + WS_SGA; break;
        case PH_GB: J.A = U; J.Bt = (bf16_t*)(ws + WS_WGB); J.M = T; J.N = DM; J.K = DM; J.lda = DM; J.kind = K_SIG; J.p0 = ws + WS_SGB; break;
        case PH_PB: J.A = (bf16_t*)(ws + WS_OCONV); J.Bt = (bf16_t*)(ws + WS_PB); J.M = T; J.N = DM; J.K = 512; J.lda = 512; J.kind = K_PROJB; J.p0 = ws + WS_SGB; J.p1 = ws + WS_SGA; break;
        case PH_WO: J.A = (bf16_t*)(ws + WS_SGB); J.Bt = (bf16_t*)(ws + WS_WO); J.M = T; J.N = DM; J.K = DM; J.lda = DM; J.kind = K_RESID; J.p0 = H; J.p1 = H; J.scale = 1.f; break;
        case PH_F2UP: J.A = U; J.Bt = (bf16_t*)(ws + WS_F2UP); J.M = T; J.N = 2 * FF; J.K = DM; J.lda = DM; J.kind = K_SWIGLU; J.p0 = HID; break;
        case PH_F2DN: J.A = HID; J.Bt = (bf16_t*)(ws + WS_F2DN); J.M = T; J.N = DM; J.K = FF; J.lda = FF; J.kind = K_RESID; J.p0 = H; J.p1 = H; J.scale = 0.5f; break;
        case PH_PP: J.A = (bf16_t*)(ws + WS_PBF); J.Bt = (bf16_t*)(ws + WS_PP); J.M = T; J.N = DM; J.K = 256; J.lda = 256; J.kind = K_ST32; J.p0 = ws + WS_TMP; break;
        case PH_PG: J.A = U; J.Bt = (bf16_t*)(ws + WS_PG); J.M = T; J.N = DM; J.K = DM; J.lda = DM; J.kind = K_PLE; J.p0 = H; J.p1 = ws + WS_TMP; break;
        default: break;
        }
        J.rowss = nullptr; J.ssout = nullptr;
        { float* ssq = (float*)(ws + WS_SUMSQ);
          switch (ph) {
          case PH_F1DN: J.p2 = U; J.ssout = ssq; break;
          case PH_WIN: case PH_WVT: case PH_GA: case PH_GB: J.rowss = ssq; break;
          case PH_WO: J.p2 = U; J.ssout = ssq + T; break;
          case PH_F2UP: J.rowss = ssq + T; break;
          case PH_F2DN: J.p2 = U; J.ssout = ssq + 2 * T; break;
          case PH_PG: J.rowss = ssq + 2 * T; break;
          default: break; } }
#if DBG_GATE
        if (ph == PH_PRO && bid == 0 && tid == 0) { *(unsigned*)ws = 0u; ((unsigned*)ws)[1] = 0u; }
#if DBG_GATE == 2
        if (ph == PH_C1K && bid < 4) {
            const int sidx = bid * 512 + tid; const int row = (int)(((long long)sidx * 7919) % T), col = (int)(((long long)sidx * 104729) % 512);
            const float* win = (const float*)a.in[8]; float g = 0.f;
            for (int k = 0; k < DM; ++k) { const float wv = __uint_as_float(f2bf(win[(size_t)k * WIN_COLS + 1304 + col]) << 16); g += __uint_as_float((unsigned)U[(size_t)row * DM + k] << 16) * wv; }
            const float got = __uint_as_float((unsigned)((const bf16_t*)(ws + WS_CB))[(size_t)row * 512 + col] << 16);
            if (!(fabsf(g - got) < 0.03f + 0.01f * fabsf(g))) { atomicOr((unsigned*)ws, 1u); atomicAdd((unsigned*)ws + 1, 1u); }
        }
#endif
#if DBG_GATE == 5
        if (ph == PH_WO && bid < 4) {
            const int sidx = bid * 512 + tid; const int row = (int)(((long long)sidx * 7919) % T), col = (int)(((long long)sidx * 104729) % 1024);
            const float* win = (const float*)a.in[8]; const float* wb = (const float*)a.in[20]; float g = 0.f, v = 0.f;
            for (int k = 0; k < DM; ++k) { const float wv = __uint_as_float(f2bf(win[(size_t)k * WIN_COLS + 3864 + col]) << 16); g += __uint_as_float((unsigned)U[(size_t)row * DM + k] << 16) * wv; }
            const bf16_t* oc = (const bf16_t*)(ws + WS_OCONV);
            for (int k = 0; k < 512; ++k) { const float wv = __uint_as_float(f2bf(wb[(size_t)k * DM + col]) << 16); v += __uint_as_float((unsigned)oc[(size_t)row * 512 + k] << 16) * wv; }
            const float ref = v / (1.0f + expf(-g)); const float got = __uint_as_float((unsigned)((const bf16_t*)(ws + WS_SGB))[(size_t)row * DM + col] << 16);
            if (DBG_STRAT) { atomicOr((unsigned*)ws, 1u); if (!(fabsf(ref - got) < 0.03f + 0.02f * fabsf(ref))) atomicAdd((unsigned*)ws + 1, 1u); }
        }
#endif
#if DBG_GATE == 3
        if (ph == PH_GA && bid < 4) {
            const int sidx = bid * 512 + tid; const int row = (int)(((long long)sidx * 7919) % T), col = (int)(((long long)sidx * 104729) % 1024);
            float ss = 0.f; for (int k = 0; k < DM; ++k) { const float hv = H[(size_t)row * DM + k]; ss += hv * hv; }
            const float ref = H[(size_t)row * DM + col] * (1.0f / sqrtf(ss * (1.f / DM) + EPSN)) * ((const float*)a.in[7])[col];
            const float got = __uint_as_float((unsigned)U[(size_t)row * DM + col] << 16);
            if (!(fabsf(ref - got) < 0.02f + 0.01f * fabsf(ref))) { atomicOr((unsigned*)ws, 1u); atomicAdd((unsigned*)ws + 1, 1u); }
        }
#endif
        if ((DBG_GATE == 1 || DBG_GATE == 4) && ph == PH_PB) J.kind = -2;
        if ((DBG_GATE == 1 || DBG_GATE == 4) && ph == PH_PB && bid < 4) {
            const int sidx = bid * 512 + tid; const int row = (int)(((long long)sidx * 7919) % T), col = (int)(((long long)sidx * 104729) % 1024);
            const float* win = (const float*)a.in[8]; float g = 0.f;
            for (int k = 0; k < DM; ++k) { const float wv = __uint_as_float(f2bf(win[(size_t)k * WIN_COLS + 3864 + col]) << 16); g += __uint_as_float((unsigned)U[(size_t)row * DM + k] << 16) * wv; }
            const float ref = 1.0f / (1.0f + expf(-g)); const float got = __uint_as_float((unsigned)((const bf16_t*)(ws + WS_SGB))[(size_t)row * DM + col] << 16);
#if DBG_GATE == 4
            if (fabsf(g) > 3.0f) { atomicOr((unsigned*)ws, 1u); atomicAdd((unsigned*)ws + 1, 1u); }
#else
            if (DBG_STRAT) { atomicOr((unsigned*)ws, 1u); if (!(fabsf(ref - got) < 0.03f)) atomicAdd((unsigned*)ws + 1, 1u); }
#endif
            { const bf16_t* wt = (const bf16_t*)(ws + WS_WGB); bool bad = false;
              for (int k = 0; k < DM; k += 37) { if (wt[(size_t)col * DM + k] != (bf16_t)f2bf(win[(size_t)k * WIN_COLS + 3864 + col])) bad = true; }
              if (bad) atomicOr((unsigned*)ws, 2u); }
        }
        if (ph == PH_FNORM) { if (*(volatile unsigned*)ws != 0u) { for (int row = gw; row < T; row += NGW) for (int j = 0; j < 4; ++j) { const float fv = (*(volatile unsigned*)ws & 2u) ? 100.f : 1.0f + 9.0f * (float)((volatile unsigned*)ws)[1] / 2048.0f; ((f32x4*)(a.out + (size_t)row * DM))[lane + 64 * j] = (f32x4){fv, fv, fv, fv}; } continue; } }
#endif
#ifdef SKIP_PH
        if (((SKIP_PH) >> ph) & 1) J.kind = -2;
#endif
        if (J.kind >= 0) {
            EpiSwitch E; E.J = J;
            E.W.ws = ws; E.W.sg = nullptr;
            pg8::Gemm g{J.A, J.Bt, J.M, J.N, J.K, J.lda}; pg8::StaticOrder S; S.init(J.M, J.N, G, (bid + J.rot) % G);
#ifndef NO_GEMM
            pg8::gemm_phase<EpiSwitch, pg8::StaticOrder, GP_ALIGN, GP_SP2>(lds, g, S, E);
#endif
#ifdef REP_PH
            if (ph == REP_PH) pg8::gemm_phase<EpiSwitch, pg8::StaticOrder, GP_ALIGN, GP_SP2>(lds, g, S, E);
#endif
        } else if (ph == PH_PRO) {
            LAS float* scr = (LAS float*)(lds + wave * 17024);
            int base = 0;
#pragma unroll
            for (int jb = 0; jb < 17; ++jb) {
                const float* W0 = nullptr; const float* W1 = nullptr; const float* gn = nullptr; int K = 0, N = 0, P = 0, pk = PK_ID; size_t dst = 0;
                switch (jb) {
                case 0: W0 = (const float*)a.in[4]; W1 = (const float*)a.in[5]; K = DM; N = FF; P = 2 * FF; pk = PK_SWIGLU; dst = WS_F1UP; break;
                case 1: W0 = (const float*)a.in[6]; K = FF; N = DM; P = DM; dst = WS_F1DN; break;
                case 2: gn = (const float*)a.in[22]; W0 = (const float*)a.in[23]; W1 = (const float*)a.in[24]; K = DM; N = FF; P = 2 * FF; pk = PK_SWIGLU; dst = WS_F2UP; break;
                case 3: W0 = (const float*)a.in[25]; K = FF; N = DM; P = DM; dst = WS_F2DN; break;
                case 4: gn = (const float*)a.in[7]; W0 = (const float*)a.in[8]; K = DM; N = WIN_COLS; P = 2816; pk = PK_WIN; dst = WS_WIN; break;
                case 15: gn = (const float*)a.in[7]; W0 = (const float*)a.in[8]; K = DM; N = WIN_COLS; P = DM; pk = PK_GA; dst = WS_WGA; break;
                case 16: gn = (const float*)a.in[7]; W0 = (const float*)a.in[8]; K = DM; N = WIN_COLS; P = DM; pk = PK_GB; dst = WS_WGB; break;
                case 5: gn = (const float*)a.in[7]; W0 = (const float*)a.in[8]; K = DM; N = WIN_COLS; P = 256; pk = PK_VT; dst = WS_WVT; break;
                case 6: W0 = (const float*)a.in[10]; K = 2048; N = 256; P = 256; dst = WS_CK1; break;
                case 7: W0 = (const float*)a.in[14]; K = 2048; N = 256; P = 256; dst = WS_CV1; break;
                case 8: W0 = (const float*)a.in[12]; K = 256; N = 64; P = 256; pk = PK_PAD64; dst = WS_CK2; break;
                case 9: W0 = (const float*)a.in[16]; K = 256; N = 64; P = 256; pk = PK_PAD64; dst = WS_CV2; break;
                case 10: W0 = (const float*)a.in[19]; K = 512; N = DM; P = DM; dst = WS_PA; break;
                case 11: W0 = (const float*)a.in[20]; K = 512; N = DM; P = DM; dst = WS_PB; break;
                case 12: W0 = (const float*)a.in[21]; K = DM; N = DM; P = DM; dst = WS_WO; break;
                case 13: gn = (const float*)a.in[26]; W0 = (const float*)a.in[27]; K = DM; N = DM; P = DM; dst = WS_PG; break;
                case 14: W0 = (const float*)a.in[28]; K = 256; N = DM; P = DM; dst = WS_PP; break;
                }
                const int nblk = P / 64, nitems = (K / 64) * nblk;
                int first = (gw - base) % NGW; if (first < 0) first += NGW;
                if (!(PRO_SKIP_T && it_ < 0)) for (int it = first; it < nitems; it += NGW) transpose_item(W0, W1, gn, K, N, pk, (bf16_t*)(ws + dst), scr, it, nblk, lane);
                base += nitems;
            }
            for (int ib = bid * 512; ib < 3 * T; ib += G * 512) ((float*)(ws + WS_SUMSQ))[ib + tid] = 0.f;
            for (int ibs = bid * 512; ibs < T * 32; ibs += 4 * G * 512) { const int ib = ibs + tid;
                int pr[4];
#pragma unroll
                for (int k = 0; k < 4; ++k) { const int idx = ib + k * G * 512; pr[k] = idx < T * 32 ? positions[idx >> 5] : 0; }
#pragma unroll
                for (int k = 0; k < 4; ++k) { const int idx = ib + k * G * 512;
                    if (idx < T * 32) {
                        const double ang = (double)pr[k] * a.invf[idx & 31];
                        const double kk = rint(ang * 0.15915494309189535);
                        double r = fma(-kk, 6.283185307179586, ang); r = fma(-kk, 2.4492935982947064e-16, r);
                        const float rf = (float)r;
                        float2 cs; cs.x = cosf(rf); cs.y = sinf(rf);
                        ((float2*)(ws + WS_ROPE))[idx] = cs; }
                    asm volatile("" ::: "memory"); }
            }
            for (int ob = bid; ob < 256; ob += G) {
                const int mat = ob >> 7, n0 = (ob & 127) * 2;
                const float* posk = (const float*)a.in[9]; const float* posv = (const float*)a.in[13]; const float* w1k = (const float*)a.in[10]; const float* w1v = (const float*)a.in[14]; const float* b1k = (const float*)a.in[11]; const float* b1v = (const float*)a.in[15];
                const float* pos = mat ? posv : posk; const float* w1 = mat ? w1v : w1k; const float* b1 = mat ? b1v : b1k;
                float s0 = 0.f, s1 = 0.f;
#pragma unroll
                for (int i = 0; i < 4; ++i) { const int kk = tid * 4 + i; const float pv = pos[kk]; const float2 wv = *(const float2*)(w1 + (size_t)kk * 256 + n0); s0 += pv * wv.x; s1 += pv * wv.y; }
                s0 = wave_sum(s0); s1 = wave_sum(s1);
                LAS float* red = (LAS float*)(lds + 137216);
                __syncthreads();
                if (lane == 0) { red[wave * 2] = s0; red[wave * 2 + 1] = s1; }
                __syncthreads();
                if (tid < 2) { float tsum = b1[n0 + tid]; for (int q = 0; q < 8; ++q) tsum += red[q * 2 + tid]; ((float*)(ws + (mat ? WS_BIASV : WS_BIASK)))[n0 + tid] = tsum; }
            }
            for (int row = gw; row < T; row += 4 * NGW) norm_rows_n<false, 4>(x, (const float*)a.in[3], U, row, NGW, lane);
        } else if ((ph == PH_PCONV || ph == PH_CONV) && G == 256 && (bid < 16 || bid >= 240)) {
        } else if (ph == PH_PCONV) {
            bf16_t* pb = (bf16_t*)(ws + WS_PBF);
            const int eb = (G == 256) ? bid - 16 : bid, EG = (G == 256) ? 224 : G;
            for (size_t i8 = (size_t)eb * 512 + tid; i8 < (size_t)T * 256 / 8; i8 += (size_t)EG * 512) { const f32x4 v0 = ((const f32x4*)pin)[2 * i8], v1 = ((const f32x4*)pin)[2 * i8 + 1]; ((u32x4*)pb)[i8] = pack8(v0, v1); }
        } else if (ph == PH_FNORM) {
            for (int row = gw; row < T; row += 4 * NGW) norm_rows_n<true, 4>(H, (const float*)a.in[29], a.out, row, NGW, lane);
        } else if (ph == PH_CONV) {
            const bf16_t* cb = (const bf16_t*)(ws + WS_CB); const bf16_t* cc = cb + (size_t)T * 512; const bf16_t* cx = cc + (size_t)T * 512; bf16_t* oc = (bf16_t*)(ws + WS_OCONV);
            const float* cw = (const float*)a.in[17]; const float* cbias = (const float*)a.in[18];
            const int eb = (G == 256) ? bid - 16 : bid, EG = (G == 256) ? 224 : G;
            for (int it = eb * 512 + tid; it < (T / 16) * 64; it += EG * 512) {
                const int c0 = (it & 63) * 8, tc0 = (it >> 6) * 16;
                f32x4 w0a = *(const f32x4*)(cw + c0), w0b = *(const f32x4*)(cw + c0 + 4), w1a = *(const f32x4*)(cw + 512 + c0), w1b = *(const f32x4*)(cw + 512 + c0 + 4);
                f32x4 w2a = *(const f32x4*)(cw + 1024 + c0), w2b = *(const f32x4*)(cw + 1024 + c0 + 4), bia = *(const f32x4*)(cbias + c0), bib = *(const f32x4*)(cbias + c0 + 4);
                f32x4 u2a = {0.f, 0.f, 0.f, 0.f}, u2b = u2a, u1a = u2a, u1b = u2a;
                if ((tc0 & (SEQ - 1)) != 0) {
                    f32x4 ca, cbb, xa, xb;
                    unpack8(*(const u32x4*)(cc + (size_t)(tc0 - 2) * 512 + c0), ca, cbb); unpack8(*(const u32x4*)(cx + (size_t)(tc0 - 2) * 512 + c0), xa, xb); u2a = ca * xa; u2b = cbb * xb;
                    unpack8(*(const u32x4*)(cc + (size_t)(tc0 - 1) * 512 + c0), ca, cbb); unpack8(*(const u32x4*)(cx + (size_t)(tc0 - 1) * 512 + c0), xa, xb); u1a = ca * xa; u1b = cbb * xb;
                }
                u32x4 ncc = *(const u32x4*)(cc + (size_t)tc0 * 512 + c0), ncx = *(const u32x4*)(cx + (size_t)tc0 * 512 + c0), ncb = *(const u32x4*)(cb + (size_t)tc0 * 512 + c0);
#pragma unroll 4
                for (int tt = 0; tt < 16; ++tt) {
                    const size_t o = (size_t)(tc0 + tt) * 512 + c0;
                    const u32x4 wcc = ncc, wcx = ncx, wcb = ncb;
                    if (tt < 15) { ncc = *(const u32x4*)(cc + o + 512); ncx = *(const u32x4*)(cx + o + 512); ncb = *(const u32x4*)(cb + o + 512); }
                    f32x4 ca, cbb, xa, xb, ba, bb;
                    unpack8(wcc, ca, cbb); unpack8(wcx, xa, xb); unpack8(wcb, ba, bb);
                    const f32x4 u0a = ca * xa, u0b = cbb * xb;
                    const f32x4 ya = w0a * u2a + w1a * u1a + w2a * u0a + bia, yb = w0b * u2b + w1b * u1b + w2b * u0b + bib;
                    *(u32x4*)(oc + o) = pack8(ba * ya, bb * yb);
                    u2a = u1a; u2b = u1b; u1a = u0a; u1b = u0b;
                }
            }
        } else if (ph == PH_ATTN) {
            AttnP P; P.q = (const bf16_t*)(ws + WS_Q); P.kcomp = (const bf16_t*)(ws + WS_KCOMP); P.vcompT = (const bf16_t*)(ws + WS_VCOMPT); P.ks = (const bf16_t*)(ws + WS_KS); P.kw = (const bf16_t*)(ws + WS_KW);
            P.VT = (const bf16_t*)(ws + WS_VT); P.gates = (const float*)(ws + WS_GATES); P.scratch = (float*)(ws + WS_CB); P.scratch2 = nullptr; P.onsa = (bf16_t*)(ws + WS_ONSA);
#ifdef ZERO_ATTN
            for (size_t i8 = (size_t)bid * 512 + tid; i8 < (size_t)T * 512 / 8; i8 += (size_t)G * 512) ((u32x4*)P.onsa)[i8] = (u32x4){0u, 0u, 0u, 0u};
#endif
#if !defined(NO_ATTN) && !defined(ZERO_ATTN)
            {
                unsigned* qctr = (unsigned*)ws + 6144; const int bgi = bid & 7;
                LAS unsigned* nxt = (LAS unsigned*)(lds + 140000);
                for (;;) {
                    if (tid == 0) nxt[0] = atomicAdd(qctr + 64 * bgi, 1u);
                    __syncthreads();
                    const unsigned un = nxt[0];
                    __syncthreads();
                    if (un >= 64u) break;
                    attn_unit(lds, P, bgi >> 1, bgi & 1, 63 - (int)un, tid, wave, lane);
                }
            }
#endif

        }
#if !SPLIT_LAUNCH
        if (ph + 1 < a.ph_hi && sync_after(ph)) { if (a.ph_lo < 0) cg::this_grid().sync();   xcd_barrier(xbar); }
#endif
#ifdef SYNC_PROBE
        if (ph == PH_PRO) for (int i_ = 0; i_ < SYNC_PROBE; ++i_) cg::this_grid().sync();
#endif
    }
}

extern "C" void kernel_launch(void* const* d_in, const int* in_sizes, int n_in, void* d_out, int out_size, void* d_ws, size_t ws_size, hipStream_t stream) {
    static int grid = 0;
    if (grid == 0) {
        if (n_in != 30 || out_size != T * DM || ws_size < WS_END) { fprintf(stderr, "kernel_launch: unexpected problem (n_in %d out %d ws %zu)\n", n_in, out_size, ws_size); grid = -1; return; }
        {
            const long long exp_sz[30] = {(long long)T * DM, (long long)T * 256, T, DM, (long long)DM * FF, (long long)DM * FF, (long long)FF * DM, DM, (long long)DM * WIN_COLS, 2048, 2048 * 256, 256, 256 * 64,
                                          2048, 2048 * 256, 256, 256 * 64, 3 * 512, 512, 512 * DM, 512 * DM, (long long)DM * DM, DM, (long long)DM * FF, (long long)DM * FF, (long long)FF * DM, DM, (long long)DM * DM, 256 * DM, DM};
            for (int i = 0; i < 30; ++i) if ((long long)in_sizes[i] != exp_sz[i]) { fprintf(stderr, "kernel_launch: input %d has %d elements, expected %lld\n", i, in_sizes[i], exp_sz[i]); grid = -1; return; }
        }
        int dev = 0, cus = 0, per_cu = 0;
        hipGetDevice(&dev); hipDeviceGetAttribute(&cus, hipDeviceAttributeMultiprocessorCount, dev);
        if (hipFuncSetAttribute((const void*)fwd_kernel, hipFuncAttributeMaxDynamicSharedMemorySize, LDS_BYTES) != hipSuccess) { fprintf(stderr, "kernel_launch: hipFuncSetAttribute failed\n"); grid = -1; return; }
        if (hipOccupancyMaxActiveBlocksPerMultiprocessor(&per_cu, (const void*)fwd_kernel, 512, LDS_BYTES) != hipSuccess || per_cu < 1) { fprintf(stderr, "kernel_launch: occupancy query says %d\n", per_cu); per_cu = 1; }
        (void)hipGetLastError();
        grid = cus * per_cu;
    }
    if (grid < 0) return;
    Args a{};
    for (int i = 0; i < 30; ++i) a.in[i] = d_in[i];
    a.out = (float*)d_out; a.ws = (unsigned char*)d_ws;
    for (int f = 0; f < 32; ++f) a.invf[f] = pow(10000.0, -(double)f / 32.0);
#if SPLIT_LAUNCH
    int lo = 0;
    for (int k = 0; k < PH_N; ++k) if (sync_after(k) || k == PH_N - 1) { a.ph_lo = lo; a.ph_hi = k + 1; hipLaunchKernelGGL(fwd_kernel, dim3(grid), dim3(512), LDS_BYTES, stream, a); lo = k + 1; }
#else
    (void)hipMemsetAsync(d_ws, 0, 32768, stream);
    a.ph_lo = 0; a.ph_hi = PH_N;
    void* args[] = {&a};
    hipError_t e = hipLaunchCooperativeKernel((const void*)fwd_kernel, dim3(grid), dim3(512), args, LDS_BYTES, stream);
    if (e != hipSuccess) fprintf(stderr, "cooperative launch failed: %s (grid %d)\n", hipGetErrorString(e), grid);
#endif
}
```

```cpp
#include <hip/hip_runtime.h>
#include <hip/hip_cooperative_groups.h>
#include <cstdio>
#include <cstdint>
#include <cmath>
namespace cg = cooperative_groups;
#ifndef SPLIT_LAUNCH
#define SPLIT_LAUNCH 0
#endif
#ifndef EPI_DRAIN
#define EPI_DRAIN 0
#endif
#ifndef DBG_GATE
#define DBG_GATE 0
#endif
#ifndef DBG_STRAT
#define DBG_STRAT 1
#endif
#ifndef ATTN_REPS
#define ATTN_REPS 1
#endif
#ifndef GP_ALIGN
#define GP_ALIGN true
#endif
#ifndef GP_SP2
#define GP_SP2 true
#endif
namespace pg8 {
#define PG8_LAS __attribute__((address_space(3)))
typedef unsigned short bf16_t;
typedef short bf16x8 __attribute__((ext_vector_type(8)));
typedef float f32x4 __attribute__((ext_vector_type(4)));
typedef unsigned u32x4 __attribute__((ext_vector_type(4)));
constexpr int BM = 256, BK = 64, HALF = 128, HTB = HALF * BK * 2  , STAGE_BYTES = 8 * HTB, NXCD = 8, WGM = 4;

__host__ __device__ __forceinline__ int lds_byte(int r, int c) { const int st = (r >> 4) * 2 + (c >> 5), rr = r & 15, cc = c & 31, ob = rr * 64 + cc * 2; return st * 1024 + (ob ^ (((ob >> 9) & 1) << 5)); }
__host__ __device__ __forceinline__ void stage_rc(int b, int& R, int& C) { const int st = b / 1024, sb = b % 1024, swz = sb ^ (((sb >> 9) & 1) << 5); R = (st >> 1) * 16 + swz / 64; C = (st & 1) * 32 + (swz % 64) / 2; }
__host__ __device__ __forceinline__ int perm32(int rho) { const int n = rho >> 4, i = rho & 15; return 8 * (i >> 2) + 4 * n + (i & 3); }

struct Unit { int pm, pn; };
struct Gemm { const bf16_t* A; const bf16_t* Bt; int M, N, K, lda; };

struct StaticOrder {
    int nM, nN, nwg, G, c;
    __host__ __device__ void init(int M, int N, int G_, int c_) { nM = M / BM; nN = N / BM; nwg = nM * nN; G = G_; c = c_; }
    __host__ __device__ bool next(int i, Unit& u) const {
        const long L = (long)i * G + c; if (L >= nwg) return false;
        int wgid = (int)L; { const int q = nwg / NXCD, r = nwg % NXCD, xcd = wgid % NXCD, off = wgid / NXCD; wgid = (xcd < r ? xcd * (q + 1) : r * (q + 1) + (xcd - r) * q) + off; }
        const int nig = WGM * nN, gid = wgid / nig, fm = gid * WGM, gsz = (nM - fm) < WGM ? (nM - fm) : WGM;
        u.pm = fm + ((wgid % nig) % gsz); u.pn = (wgid % nig) / gsz; return true;
    }
    __device__ __forceinline__ void a_ready(const Unit&) const {}
    __device__ __forceinline__ void done(const Unit&) const {}
};

template <class Epi, class Sched, bool ALIGN_EPI = false, bool SP2 = false>
__device__ __forceinline__ void gemm_phase(PG8_LAS unsigned char* lds, const Gemm g, const Sched& S, const Epi& E) {
    int tid_ = threadIdx.x; asm volatile("" : "+v"(tid_));
    const int tid = tid_, wid = __builtin_amdgcn_readfirstlane(tid >> 6), lane = tid & 63, wr = wid >> 2, wc = wid & 3, fr = lane & 15, fq = lane >> 4;
    const int K = g.K, nt = K / BK;
    unsigned voffA[2], voffB[2];
#pragma unroll
    for (int i = 0; i < 2; ++i) { int R, C; stage_rc(tid * 16 + i * 8192, R, C); const int Rb = Epi::PERM ? ((R & ~31) + perm32(R & 31)) : R;
        voffA[i] = (unsigned)(R * g.lda + C) * 2u; voffB[i] = (unsigned)(Rb * K + C) * 2u; }
    const size_t kstep = (size_t)(BK * 2);
    const size_t hstepA = (size_t)HALF * g.lda * 2, hstepB = (size_t)HALF * K * 2;
    const size_t tstepA = 2 * hstepA, tstepB = 2 * hstepB;
    const unsigned ldsw = (unsigned)wid * 1024u;
    const int aoff = lds_byte(wr * 64 + fr, fq * 8), boff = lds_byte(wc * 32 + fr, fq * 8);
#define PG8_SA(b, h) (((b) * 2 + (h)) * HTB)
#define PG8_SB(b, h) ((4 + (b) * 2 + (h)) * HTB)
#define PG8_STAGE(bufoff, gbase, voff) do { _Pragma("unroll") for (int _i = 0; _i < 2; ++_i) \
        __builtin_amdgcn_global_load_lds((const unsigned*)((const char*)(gbase) + (voff)[_i]), (PG8_LAS unsigned*)(lds + (bufoff) + ldsw + _i * 8192), 16, 0, 0); } while (0)
#define PG8_LDA(dst, b, h) do { _Pragma("unroll") for (int m = 0; m < 4; ++m) _Pragma("unroll") for (int k = 0; k < 2; ++k) dst[m][k] = *(const PG8_LAS bf16x8*)(lds + PG8_SA(b, h) + aoff + m * 2048 + k * 1024); } while (0)
#define PG8_LDB(dst, b, h) do { _Pragma("unroll") for (int n = 0; n < 2; ++n) _Pragma("unroll") for (int k = 0; k < 2; ++k) dst[n][k] = *(const PG8_LAS bf16x8*)(lds + PG8_SB(b, h) + boff + n * 2048 + k * 1024); } while (0)
#define PG8_MMA(ai, bj, At, Bt) do { __builtin_amdgcn_s_setprio(1); _Pragma("unroll") for (int m = 0; m < 4; ++m) _Pragma("unroll") for (int n = 0; n < 2; ++n) _Pragma("unroll") for (int k = 0; k < 2; ++k) \
        acc[ai][bj][m][n] = __builtin_amdgcn_mfma_f32_16x16x32_bf16(Bt[n][k], At[m][k], acc[ai][bj][m][n], 0, 0, 0); __builtin_amdgcn_s_setprio(0); } while (0)
#define PG8_WAIT_V(n) asm volatile("s_waitcnt vmcnt(" #n ")" ::: "memory")
#define PG8_WAIT_L(n) asm volatile("s_waitcnt lgkmcnt(" #n ")" ::: "memory")
#define PG8_BAR __builtin_amdgcn_s_barrier()
#define PG8_SCHED __builtin_amdgcn_sched_barrier(0)
    Unit cur, nxt; int ui = 0;
    if (!S.next(0, cur)) return;
    f32x4 acc[2][2][4][2];
#pragma unroll
    for (int a = 0; a < 2; ++a)
#pragma unroll
        for (int b = 0; b < 2; ++b)
#pragma unroll
            for (int m = 0; m < 4; ++m)
#pragma unroll
                for (int n = 0; n < 2; ++n) acc[a][b][m][n] = (f32x4){0.f, 0.f, 0.f, 0.f};
    bf16x8 At[4][2], B0[2][2], B1[2][2];
    const char* cA = (const char*)g.A + (size_t)cur.pm * tstepA; const char* cB = (const char*)g.Bt + (size_t)cur.pn * tstepB;
    S.a_ready(cur);
    if constexpr (SP2) {
        PG8_STAGE(PG8_SB(0, 0), cB, voffB); PG8_STAGE(PG8_SB(0, 1), cB + hstepB, voffB); PG8_STAGE(PG8_SA(0, 0), cA, voffA); PG8_STAGE(PG8_SA(0, 1), cA + hstepA, voffA);
        if (wr == 1) PG8_BAR;
        PG8_WAIT_V(2); PG8_BAR;
        PG8_STAGE(PG8_SB(1, 0), cB + kstep, voffB); PG8_STAGE(PG8_SA(1, 0), cA + kstep, voffA); PG8_STAGE(PG8_SB(1, 1), cB + hstepB + kstep, voffB);
        PG8_WAIT_V(6); PG8_BAR;
    } else {
        PG8_STAGE(PG8_SB(0, 0), cB, voffB); PG8_STAGE(PG8_SA(0, 0), cA, voffA); PG8_STAGE(PG8_SB(0, 1), cB + hstepB, voffB); PG8_STAGE(PG8_SA(0, 1), cA + hstepA, voffA);
        if (wr == 1) PG8_BAR;
        PG8_WAIT_V(4); PG8_BAR;
        PG8_STAGE(PG8_SB(1, 0), cB + kstep, voffB); PG8_STAGE(PG8_SA(1, 0), cA + kstep, voffA); PG8_STAGE(PG8_SB(1, 1), cB + hstepB + kstep, voffB);
        PG8_WAIT_V(6); PG8_BAR;
    }
    for (;;) {
        const bool has_next = S.next(ui + 1, nxt);
        const char* nA = has_next ? (const char*)g.A + (size_t)nxt.pm * tstepA : cA; const char* nB = has_next ? (const char*)g.Bt + (size_t)nxt.pn * tstepB : cB;
        for (int t = 0; t < nt; t += 2) {
            const bool last = (t == nt - 2);
            const char* a1 = cA + (size_t)(t + 1) * kstep;
            const char* a2 = last ? nA : cA + (size_t)(t + 2) * kstep; const char* b2 = last ? nB : cB + (size_t)(t + 2) * kstep;
            const char* a3 = a2 + kstep; const char* b3 = b2 + kstep;
            if (last && has_next) S.a_ready(nxt);
            if constexpr (SP2) {
            PG8_LDB(B0, 0, 0); PG8_LDB(B1, 0, 1); PG8_SCHED; PG8_LDA(At, 0, 0); PG8_STAGE(PG8_SA(1, 1), a1 + hstepA, voffA);
            PG8_WAIT_V(8); PG8_WAIT_L(0); PG8_BAR; PG8_MMA(0, 0, At, B0); PG8_MMA(0, 1, At, B1); PG8_BAR; PG8_SCHED;
            PG8_LDA(At, 0, 1); PG8_STAGE(PG8_SB(0, 0), b2, voffB); PG8_STAGE(PG8_SB(0, 1), b2 + hstepB, voffB); PG8_STAGE(PG8_SA(0, 0), a2, voffA);
            PG8_WAIT_V(8); PG8_WAIT_L(0); PG8_BAR; PG8_MMA(1, 0, At, B0); PG8_MMA(1, 1, At, B1); PG8_BAR; PG8_SCHED;
            PG8_LDB(B0, 1, 0); PG8_LDB(B1, 1, 1); PG8_SCHED; PG8_LDA(At, 1, 0); PG8_STAGE(PG8_SA(0, 1), a2 + hstepA, voffA);
            PG8_WAIT_V(8); PG8_WAIT_L(0); PG8_BAR; PG8_MMA(0, 0, At, B0); PG8_MMA(0, 1, At, B1); PG8_BAR; PG8_SCHED;
            PG8_LDA(At, 1, 1); PG8_STAGE(PG8_SB(1, 0), b3, voffB); PG8_STAGE(PG8_SB(1, 1), b3 + hstepB, voffB); PG8_STAGE(PG8_SA(1, 0), a3, voffA);
            PG8_WAIT_V(8); PG8_WAIT_L(0); PG8_BAR; PG8_MMA(1, 0, At, B0); PG8_MMA(1, 1, At, B1); PG8_BAR; PG8_SCHED;
            } else {
            PG8_LDB(B0, 0, 0); PG8_SCHED; PG8_LDA(At, 0, 0); PG8_STAGE(PG8_SA(1, 1), a1 + hstepA, voffA);
            PG8_WAIT_L(8); PG8_BAR; PG8_WAIT_L(0); PG8_MMA(0, 0, At, B0); PG8_BAR; PG8_SCHED;
            PG8_LDB(B1, 0, 1); PG8_STAGE(PG8_SB(0, 0), b2, voffB);
            PG8_BAR; PG8_WAIT_L(0); PG8_MMA(0, 1, At, B1); PG8_BAR;
            PG8_LDA(At, 0, 1); PG8_STAGE(PG8_SA(0, 0), a2, voffA);
            PG8_BAR; PG8_WAIT_L(0); PG8_MMA(1, 0, At, B0); PG8_BAR; PG8_SCHED;
            PG8_STAGE(PG8_SB(0, 1), b2 + hstepB, voffB);
            PG8_WAIT_V(6); PG8_BAR; PG8_MMA(1, 1, At, B1); PG8_BAR;
            PG8_LDB(B0, 1, 0); PG8_SCHED; PG8_LDA(At, 1, 0); PG8_STAGE(PG8_SA(0, 1), a2 + hstepA, voffA);
            PG8_WAIT_L(8); PG8_BAR; PG8_WAIT_L(0); PG8_MMA(0, 0, At, B0); PG8_BAR; PG8_SCHED;
            PG8_LDB(B1, 1, 1); PG8_STAGE(PG8_SB(1, 0), b3, voffB);
            PG8_BAR; PG8_WAIT_L(0); PG8_MMA(0, 1, At, B1); PG8_BAR;
            PG8_LDA(At, 1, 1); PG8_STAGE(PG8_SA(1, 0), a3, voffA);
            PG8_BAR; PG8_WAIT_L(0); PG8_MMA(1, 0, At, B0); PG8_BAR; PG8_SCHED;
            PG8_STAGE(PG8_SB(1, 1), b3 + hstepB, voffB);
            PG8_WAIT_V(6); PG8_BAR; PG8_MMA(1, 1, At, B1); PG8_BAR;
            }
        }
        if constexpr (ALIGN_EPI) { if (wr == 0) PG8_BAR; }
        if constexpr (!Epi::AFTER_DRAIN) { E(acc, cur, wr, wc, fr, fq); S.done(cur); }
        if (!has_next) break;
#pragma unroll
        for (int a = 0; a < 2; ++a)
#pragma unroll
            for (int b = 0; b < 2; ++b)
#pragma unroll
                for (int m = 0; m < 4; ++m)
#pragma unroll
                    for (int n = 0; n < 2; ++n) acc[a][b][m][n] = (f32x4){0.f, 0.f, 0.f, 0.f};
        cur = nxt; cA = nA; cB = nB; ++ui;
        if constexpr (ALIGN_EPI) { if (wr == 1) PG8_BAR; }
    }
    PG8_WAIT_V(0);
    if constexpr (!ALIGN_EPI) { if (wr == 0) PG8_BAR; }
    PG8_BAR;
    if constexpr (Epi::AFTER_DRAIN) { E.fused(acc, cur, wr, wc, fr, fq, lds, wid, lane); S.done(cur); }
#undef PG8_SA
#undef PG8_SB
#undef PG8_STAGE
#undef PG8_LDA
#undef PG8_LDB
#undef PG8_MMA
#undef PG8_WAIT_V
#undef PG8_WAIT_L
#undef PG8_BAR
#undef PG8_SCHED
}
}

using pg8::bf16_t; using pg8::bf16x8; using pg8::f32x4; using pg8::u32x4;
typedef unsigned u32x2 __attribute__((ext_vector_type(2)));
#define LAS __attribute__((address_space(3)))

constexpr int NB = 4, SEQ = 8192, T = NB * SEQ, DM = 1024, FF = 2816;
constexpr float LOG2E = 1.4426950408889634f;
constexpr float QSCALE = 0.125f * LOG2E;
constexpr float EPSN = 1e-6f;
constexpr int WIN_COLS = 4888;
constexpr int NWAVES = 8;
constexpr int LDS_BYTES = 147456;

constexpr size_t MiB = 1u << 20;
constexpr size_t WS_F1UP = 1 * MiB, WS_F1DN = 12 * MiB, WS_F2UP = 18 * MiB, WS_F2DN = 29 * MiB, WS_WIN = 35 * MiB, WS_WGA = 41 * MiB, WS_WGB = 43 * MiB, WS_WVT = 45 * MiB;
constexpr size_t WS_CK1 = 46 * MiB, WS_CV1 = 47 * MiB, WS_CK2 = 48 * MiB, WS_CV2 = 48 * MiB + 256 * 1024, WS_PA = 49 * MiB, WS_PB = 50 * MiB;
constexpr size_t WS_WO = 51 * MiB, WS_PG = 53 * MiB, WS_PP = 55 * MiB, WS_BIASK = 512 * 1024, WS_BIASV = 512 * 1024 + 4096, WS_ROPE = 57 * MiB;
constexpr size_t WS_U = 72 * MiB;
constexpr size_t WS_H = 136 * MiB;
constexpr size_t WS_BIG = 264 * MiB;
constexpr size_t WS_Q = WS_BIG, WS_CB = WS_BIG + 32 * MiB, WS_KCR = WS_BIG + 128 * MiB, WS_VCR = WS_BIG + 136 * MiB, WS_KS = WS_BIG + 144 * MiB, WS_KW = WS_BIG + 152 * MiB, WS_VT = WS_BIG + 160 * MiB;
constexpr size_t WS_TMP = WS_BIG, WS_PBF = 56 * MiB;
constexpr size_t WS_SUMSQ = 65536;
constexpr size_t WS_SGA = WS_BIG, WS_SGB = WS_BIG + 64 * MiB;
constexpr size_t WS_TAIL = 440 * MiB;
constexpr size_t WS_GATES = WS_TAIL, WS_HCK = WS_TAIL + 3 * MiB, WS_HCV = WS_TAIL + 5 * MiB, WS_KCOMP = WS_TAIL + 7 * MiB, WS_VCOMPT = WS_TAIL + 7 * MiB + 512 * 1024;
constexpr size_t WS_ONSA = WS_TAIL + 8 * MiB, WS_OCONV = WS_TAIL + 40 * MiB, WS_END = 512 * MiB;

__device__ __forceinline__ unsigned cvt_pk_bf16(float lo, float hi) { unsigned r; asm volatile("s_nop 1\n\tv_cvt_pk_bf16_f32 %0, %1, %2" : "=v"(r) : "v"(lo), "v"(hi)); return r; }
__device__ __forceinline__ unsigned cvt_pk_bf16_t(float lo, float hi) { unsigned r; asm volatile("s_nop 1\n\tv_cvt_pk_bf16_f32 %0, %1, %2\n\ts_nop 1" : "=v"(r) : "v"(lo), "v"(hi)); return r; }
__device__ __forceinline__ u32x2 pack4_t(f32x4 a) { u32x2 w; w.x = cvt_pk_bf16_t(a[0], a[1]); w.y = cvt_pk_bf16_t(a[2], a[3]); return w; }
__device__ __forceinline__ u32x4 pack8(f32x4 a, f32x4 b) { u32x4 w; w.x = cvt_pk_bf16(a[0], a[1]); w.y = cvt_pk_bf16(a[2], a[3]); w.z = cvt_pk_bf16(b[0], b[1]); w.w = cvt_pk_bf16(b[2], b[3]); return w; }
__device__ __forceinline__ u32x2 pack4(f32x4 a) { u32x2 w; w.x = cvt_pk_bf16(a[0], a[1]); w.y = cvt_pk_bf16(a[2], a[3]); return w; }
__device__ __forceinline__ float bf_lo(unsigned w) { return __uint_as_float(w << 16); }
__device__ __forceinline__ float bf_hi(unsigned w) { return __uint_as_float(w & 0xffff0000u); }
__device__ __forceinline__ void unpack8(u32x4 w, f32x4& a, f32x4& b) { a[0] = bf_lo(w.x); a[1] = bf_hi(w.x); a[2] = bf_lo(w.y); a[3] = bf_hi(w.y); b[0] = bf_lo(w.z); b[1] = bf_hi(w.z); b[2] = bf_lo(w.w); b[3] = bf_hi(w.w); }
__device__ __forceinline__ float fsigmoid(float x) { return __builtin_amdgcn_rcpf(1.0f + __builtin_amdgcn_exp2f(-x * LOG2E)); }
__device__ __forceinline__ f32x4 sig4(f32x4 v) { f32x4 r; r[0] = fsigmoid(v[0]); r[1] = fsigmoid(v[1]); r[2] = fsigmoid(v[2]); r[3] = fsigmoid(v[3]); return r; }
__device__ __forceinline__ float gelu_tanh(float x) { const float z = 1.5957691216057308f * (x + 0.044715f * x * x * x); return x * fsigmoid(z); }

enum { K_SWIGLU = 0, K_RESID, K_WIN, K_VT, K_GELU, K_KC, K_VCT, K_PROJA, K_PROJB, K_ST32, K_SIG, K_PLE };
struct Job { const bf16_t* A; const bf16_t* Bt; int M, N, K, lda, kind, rot; void* p0; void* p1; void* p2; float scale; const float* rowss; float* ssout; };
struct WinPtrs { unsigned char* ws; bf16_t* sg; };

struct EpiSwitch {
    static constexpr bool PERM = true, AFTER_DRAIN = false;
    Job J; WinPtrs W;
    template <class F> __device__ __forceinline__ void loop(const f32x4 (&acc)[2][2][4][2], const pg8::Unit& u, int wr, int wc, int fr, int fq, const F& f) const {
        const int row0 = u.pm * 256 + wr * 64 + fr, col0 = u.pn * 256 + wc * 32 + 8 * fq;
#pragma unroll
        for (int ai = 0; ai < 2; ++ai)
#pragma unroll
            for (int m = 0; m < 4; ++m)
#pragma unroll
                for (int bj = 0; bj < 2; ++bj) f(row0 + ai * 128 + m * 16, col0 + bj * 128, acc[ai][bj][m][0], acc[ai][bj][m][1]);
    }
    template <class F> __device__ __forceinline__ void loop_rs(const f32x4 (&acc)[2][2][4][2], const pg8::Unit& u, int wr, int wc, int fr, int fq, const float* rowss, const F& f) const {
        const int row0 = u.pm * 256 + wr * 64 + fr, col0 = u.pn * 256 + wc * 32 + 8 * fq;
#pragma unroll
        for (int ai = 0; ai < 2; ++ai)
#pragma unroll
            for (int m = 0; m < 4; ++m) { const int row = row0 + ai * 128 + m * 16; const float rs = __builtin_amdgcn_rsqf(rowss[row] * (1.f / DM) + EPSN);
#pragma unroll
                for (int bj = 0; bj < 2; ++bj) f(row, col0 + bj * 128, acc[ai][bj][m][0] * rs, acc[ai][bj][m][1] * rs); }
    }
    __device__ __forceinline__ void operator()(const f32x4 (&acc)[2][2][4][2], const pg8::Unit& u, int wr, int wc, int fr, int fq) const {
        asm volatile("s_nop 7\n\ts_nop 7\n\ts_nop 7" ::: "memory");
#ifndef EPI_MASK
#define EPI_MASK 0xffff
#endif
#define EPI_ON(k) ((EPI_MASK >> (k)) & 1)
        switch (J.kind) {
        case K_SWIGLU: if (EPI_ON(K_SWIGLU)) { bf16_t* hid = (bf16_t*)J.p0; const float* rowss = J.rowss;
            const int row0 = u.pm * 256 + wr * 64 + fr, hcol = u.pn * 128 + wc * 16 + 4 * (fq & ~1) + 64 * (fq & 1);
#pragma unroll
            for (int ai = 0; ai < 2; ++ai)
#pragma unroll
                for (int m = 0; m < 4; ++m) { const int row = row0 + ai * 128 + m * 16; const float rs = rowss ? __builtin_amdgcn_rsqf(rowss[row] * (1.f / DM) + EPSN) : 1.0f;
                    u32x2 pk[2];
#pragma unroll
                    for (int bj = 0; bj < 2; ++bj) { f32x4 h;
#pragma unroll
                        for (int i = 0; i < 4; ++i) { const float g = acc[ai][bj][m][0][i] * rs, up = acc[ai][bj][m][1][i] * rs; h[i] = g * fsigmoid(g) * up; }
                        pk[bj] = pack4_t(h); }
                    const u32x2 sx = __builtin_amdgcn_permlane16_swap(pk[0].x, pk[1].x, false, false), sy = __builtin_amdgcn_permlane16_swap(pk[0].y, pk[1].y, false, false);
                    const u32x4 o = {sx.x, sy.x, sx.y, sy.y};
                    *(u32x4*)(hid + (size_t)row * FF + hcol) = o; } } break;
        case K_RESID: if (EPI_ON(K_RESID)) { const float* base = (const float*)J.p0; float* out = (float*)J.p1; bf16_t* hb = (bf16_t*)J.p2; float* ssout = J.ssout; const float sc = J.scale;
            const int row0 = u.pm * 256 + wr * 64 + fr, col0 = u.pn * 256 + wc * 32 + 8 * fq;
#pragma unroll
            for (int ai = 0; ai < 2; ++ai)
#pragma unroll
                for (int m = 0; m < 4; ++m) { const int row = row0 + ai * 128 + m * 16; float ss = 0.f;
#pragma unroll
                    for (int bj = 0; bj < 2; ++bj) { const size_t o = (size_t)row * DM + col0 + bj * 128;
                        const f32x4 h0 = *(const f32x4*)(base + o) + acc[ai][bj][m][0] * sc, h1 = *(const f32x4*)(base + o + 4) + acc[ai][bj][m][1] * sc;
                        *(f32x4*)(out + o) = h0; *(f32x4*)(out + o + 4) = h1; *(u32x4*)(hb + o) = pack8(h0, h1);
                        ss += (h0[0] * h0[0] + h0[1] * h0[1]) + (h0[2] * h0[2] + h0[3] * h0[3]) + (h1[0] * h1[0] + h1[1] * h1[1]) + (h1[2] * h1[2] + h1[3] * h1[3]); }
                    ss += __shfl_xor(ss, 16); ss += __shfl_xor(ss, 32);
                    if (fq == 0) atomicAdd(ssout + row, ss); } } break;
        case K_WIN: if (EPI_ON(K_WIN)) {
            unsigned char* const wsb = W.ws;
            bf16_t* const Wq = (bf16_t*)(wsb + WS_Q); bf16_t* const Wvcr = (bf16_t*)(wsb + WS_VCR); bf16_t* const Wcb = (bf16_t*)(wsb + WS_CB); float* const Wgates = (float*)(wsb + WS_GATES); const float* const Wrope = (const float*)(wsb + WS_ROPE);
            loop_rs(acc, u, wr, wc, fr, fq, J.rowss, [=](int row, int col, f32x4 v0, f32x4 v1) {
                const int b = row >> 13, t = row & 8191;
                if (col < 1024) {
                    if (col >= 640 && col < 768) { const int cc = col - 640, g = cc >> 6, d0 = cc & 63;
                        *(u32x4*)(Wvcr + ((size_t)((b * 2 + g) * SEQ + t)) * 64 + d0) = pack8(v0, v1);
                    } else {
                        const int q8 = (col & 63) >> 3;
                        const f32x4 r0 = *(const f32x4*)(Wrope + (size_t)row * 64 + 8 * q8), r1 = *(const f32x4*)(Wrope + (size_t)row * 64 + 8 * q8 + 4);
                        const float c[4] = {r0[0], r0[2], r1[0], r1[2]}, s[4] = {r0[1], r0[3], r1[1], r1[3]};
                        float sc = 1.f; bf16_t* dst;
                        if (col < 512) { dst = Wq + (size_t)row * 512 + (col & ~63) + 4 * q8; sc = QSCALE; }
                        else { const size_t boff = col < 640 ? WS_KCR : (col < 896 ? WS_KS : WS_KW); bf16_t* bp = (bf16_t*)(wsb + boff); const int g = (col >> 6) & 1; dst = bp + ((size_t)((b * 2 + g) * SEQ + t)) * 64 + 4 * q8; }
                        f32x4 o1, o2;
#pragma unroll
                        for (int i = 0; i < 4; ++i) { o1[i] = (v0[i] * c[i] - v1[i] * s[i]) * sc; o2[i] = (v1[i] * c[i] + v0[i] * s[i]) * sc; }
                        *(u32x2*)dst = pack4(o1); *(u32x2*)(dst + 32) = pack4(o2);
                    }
                } else if (col < 2560) { const int cc = col - 1024, which = cc >> 9, c = cc & 511;
                    *(u32x4*)(Wcb + (size_t)which * T * 512 + (size_t)row * 512 + c) = pack8(v0, v1);
                } else { const int cc = col - 2560;
                    if (cc < 24) { float* gp = Wgates + (size_t)row * 24 + cc; *(f32x4*)gp = sig4(v0); *(f32x4*)(gp + 4) = sig4(v1); }
                } }); } break;
        case K_VT: if (EPI_ON(K_VT)) { bf16_t* vt = (bf16_t*)J.p0;
            const float* css = J.rowss;
            loop(acc, u, wr, wc, fr, fq, [=](int row, int col, f32x4 v0, f32x4 v1) { const f32x4 s0 = *(const f32x4*)(css + col), s1 = *(const f32x4*)(css + col + 4);
#pragma unroll
                for (int i = 0; i < 4; ++i) { v0[i] *= __builtin_amdgcn_rsqf(s0[i] * (1.f / DM) + EPSN); v1[i] *= __builtin_amdgcn_rsqf(s1[i] * (1.f / DM) + EPSN); }
                *(u32x4*)(vt + (size_t)row * T + col) = pack8(v0, v1); }); } break;
        case K_GELU: if (EPI_ON(K_GELU)) { bf16_t* out = (bf16_t*)J.p0; const float* bias = (const float*)J.p1;
            loop(acc, u, wr, wc, fr, fq, [=](int row, int col, f32x4 v0, f32x4 v1) { const f32x4 b0 = *(const f32x4*)(bias + col), b1 = *(const f32x4*)(bias + col + 4); f32x4 a, c;
#pragma unroll
                for (int i = 0; i < 4; ++i) { a[i] = gelu_tanh(v0[i] + b0[i]); c[i] = gelu_tanh(v1[i] + b1[i]); }
                *(u32x4*)(out + (size_t)row * 256 + col) = pack8(a, c); }); } break;
        case K_KC: if (EPI_ON(K_KC)) { bf16_t* kc = (bf16_t*)J.p0;
            loop(acc, u, wr, wc, fr, fq, [=](int row, int col, f32x4 v0, f32x4 v1) { if (col < 64) *(u32x4*)(kc + (size_t)row * 64 + col) = pack8(v0, v1); }); } break;
        case K_VCT: if (EPI_ON(K_VCT)) { bf16_t* vct = (bf16_t*)J.p0;
            loop(acc, u, wr, wc, fr, fq, [=](int row, int col, f32x4 v0, f32x4 v1) { if (row < 64) *(u32x4*)(vct + (size_t)row * 4096 + col) = pack8(v0, v1); }); } break;
        case K_PROJA: if (EPI_ON(K_PROJA)) { bf16_t* sg = (bf16_t*)J.p0;
            loop(acc, u, wr, wc, fr, fq, [=](int row, int col, f32x4 v0, f32x4 v1) { const size_t o = (size_t)row * DM + col; f32x4 s0, s1; unpack8(*(const u32x4*)(sg + o), s0, s1);
                *(u32x4*)(sg + o) = pack8(s0 * v0, s1 * v1); }); } break;
        case K_PROJB: if (EPI_ON(K_PROJB)) { bf16_t* sg = (bf16_t*)J.p0; const bf16_t* tmp = (const bf16_t*)J.p1;
            loop(acc, u, wr, wc, fr, fq, [=](int row, int col, f32x4 v0, f32x4 v1) { const size_t o = (size_t)row * DM + col; f32x4 s0, s1, t0, t1; unpack8(*(const u32x4*)(sg + o), s0, s1); unpack8(*(const u32x4*)(tmp + o), t0, t1);
#ifdef X3_GATE_PLUS_HALF
                s0 = s0 + 0.5f; s1 = s1 + 0.5f;
#endif
                *(u32x4*)(sg + o) = pack8(t0 + s0 * v0, t1 + s1 * v1); }); } break;
        case K_SIG: if (EPI_ON(K_SIG)) { bf16_t* sg = (bf16_t*)J.p0;
            loop_rs(acc, u, wr, wc, fr, fq, J.rowss, [=](int row, int col, f32x4 v0, f32x4 v1) {
#ifdef X4_SIG_CONST
                const f32x4 hf = {0.5f, 0.5f, 0.5f, 0.5f}; *(u32x4*)(sg + (size_t)row * DM + col) = pack8(hf + v0 * 0.f, hf + v1 * 0.f);
#else
#ifdef X6_SCALE
                *(u32x4*)(sg + (size_t)row * DM + col) = pack8(sig4(v0 * X6_SCALE), sig4(v1 * X6_SCALE));
#else
                *(u32x4*)(sg + (size_t)row * DM + col) = pack8(sig4(v0), sig4(v1));
#endif
#endif
                }); } break;
        case K_ST32: if (EPI_ON(K_ST32)) { bf16_t* tmp = (bf16_t*)J.p0;
            loop(acc, u, wr, wc, fr, fq, [=](int row, int col, f32x4 v0, f32x4 v1) { *(u32x4*)(tmp + (size_t)row * DM + col) = pack8(v0, v1); }); } break;
        default: if (EPI_ON(K_PLE)) { float* H = (float*)J.p0; const bf16_t* tmp = (const bf16_t*)J.p1;
            loop_rs(acc, u, wr, wc, fr, fq, J.rowss, [=](int row, int col, f32x4 v0, f32x4 v1) { const size_t o = (size_t)row * DM + col;
                f32x4 t0, t1; unpack8(*(const u32x4*)(tmp + o), t0, t1); const f32x4 h0 = *(const f32x4*)(H + o), h1 = *(const f32x4*)(H + o + 4);
                *(f32x4*)(H + o) = h0 + sig4(v0) * t0; *(f32x4*)(H + o + 4) = h1 + sig4(v1) * t1; }); } break;
        }
#if EPI_DRAIN
        asm volatile("s_waitcnt vmcnt(0)" ::: "memory");
#endif
    }
};

__device__ __forceinline__ float wave_sum(float v) {
#pragma unroll
    for (int o = 1; o < 64; o <<= 1) v += __shfl_xor(v, o);
    return v;
}
enum { PK_ID = 0, PK_SWIGLU, PK_WIN, PK_VT, PK_PAD64, PK_GA, PK_GB };
__device__ __forceinline__ int rope_perm(int j) { const int head = j >> 6, jj = j & 63, q8 = jj >> 3, w = jj & 7; return head * 64 + (w < 4 ? 4 * q8 + w : 32 + 4 * q8 + (w - 4)); }
__device__ __forceinline__ int src_col(int pk, int p, int& which) {
    which = 0;
    switch (pk) {
    case PK_ID: return p;
    case PK_SWIGLU: { const int grp = p >> 3, w = p & 7; which = (w >= 4); return grp * 4 + (w & 3); }
    case PK_WIN: {
        if (p < 512) return rope_perm(p);
        if (p < 640) return 512 + rope_perm(p - 512);
        if (p < 768) return p;
        if (p < 896) return 768 + rope_perm(p - 768);
        if (p < 1024) return 1024 + rope_perm(p - 896);
        if (p < 2560) return 1304 + (p - 1024);
        return (p - 2560) < 24 ? 1280 + (p - 2560) : -1; }
    case PK_VT: return p < 128 ? 896 + p : 1152 + (p - 128);
    case PK_GA: return 2840 + p;
    case PK_GB: return 3864 + p;
    default: return p < 64 ? p : -1;
    }
}
__device__ __forceinline__ unsigned f2bf(float f) { unsigned u = __builtin_bit_cast(unsigned, f); return (u + 0x7fffu + ((u >> 16) & 1u)) >> 16; }
__device__ __forceinline__ unsigned pk2(float lo, float hi) { return f2bf(lo) | (f2bf(hi) << 16); }
__device__ __forceinline__ void transpose_item(const float* W0, const float* W1, const float* gain, int K, int N, int pk, bf16_t* WT, LAS float* scr, int item, int nblk, int lane) {
    const int kb = item / nblk, nb = item % nblk, k0 = 64 * kb, p0 = 64 * nb;
    const int cg = lane & 15;
    int which; const int sc = src_col(pk, p0 + 4 * cg, which);
    const float* W = which ? W1 : W0;
    f32x4 v[16];
#pragma unroll
    for (int i = 0; i < 16; ++i) { const int kk = 4 * i + (lane >> 4);
        v[i] = sc >= 0 ? *(const f32x4*)(W + (size_t)(k0 + kk) * N + sc) * (gain ? gain[k0 + kk] : 1.0f) : (f32x4){0.f, 0.f, 0.f, 0.f}; }
#pragma unroll
    for (int i = 0; i < 16; ++i) { const int kk = 4 * i + (lane >> 4); LAS float* d = scr + kk * 65 + 4 * cg; d[0] = v[i][0]; d[1] = v[i][1]; d[2] = v[i][2]; d[3] = v[i][3]; }
    asm volatile("s_waitcnt lgkmcnt(0)" ::: "memory");
    const int c = lane & 7;
#pragma unroll
    for (int j = 0; j < 8; ++j) { const int n = (lane >> 3) + 8 * j; const LAS float* s = scr + (8 * c) * 65 + n;
        u32x4 o; o.x = pk2(s[0 * 65], s[1 * 65]); o.y = pk2(s[2 * 65], s[3 * 65]); o.z = pk2(s[4 * 65], s[5 * 65]); o.w = pk2(s[6 * 65], s[7 * 65]);
        *(u32x4*)(WT + (size_t)(p0 + n) * K + k0 + 8 * c) = o; }
    asm volatile("s_waitcnt lgkmcnt(0)" ::: "memory");
}
template <bool OUT32> __device__ __forceinline__ void norm_row(const float* xrow, const float* gain, void* orow, int lane) {
    const f32x4* xr = (const f32x4*)xrow + lane; const f32x4* gr = (const f32x4*)gain + lane;
    f32x4 v[4]; float s = 0.f;
#pragma unroll
    for (int j = 0; j < 4; ++j) { v[j] = xr[64 * j]; s += (v[j].x * v[j].x + v[j].y * v[j].y) + (v[j].z * v[j].z + v[j].w * v[j].w); }
    const float r = 1.0f / sqrtf(wave_sum(s) * (1.f / DM) + EPSN);
#pragma unroll
    for (int j = 0; j < 4; ++j) { const f32x4 o = v[j] * r * gr[64 * j];
        if (OUT32) ((f32x4*)orow)[lane + 64 * j] = o; else ((u32x2*)orow)[lane + 64 * j] = pack4(o); }
}

template <bool OUT32, int NR> __device__ __forceinline__ void norm_rows_n(const float* xbase, const float* gain, void* obase, int row0, int rstride, int lane) {
    f32x4 v[NR][4];
#pragma unroll
    for (int r = 0; r < NR; ++r) { const f32x4* xr = (const f32x4*)(xbase + (size_t)(row0 + r * rstride) * DM) + lane;
#pragma unroll
        for (int j = 0; j < 4; ++j) v[r][j] = xr[64 * j]; }
    const f32x4* gr = (const f32x4*)gain + lane; f32x4 gv[4];
#pragma unroll
    for (int j = 0; j < 4; ++j) gv[j] = gr[64 * j];
#pragma unroll
    for (int r = 0; r < NR; ++r) { float s = 0.f;
#pragma unroll
        for (int j = 0; j < 4; ++j) s += (v[r][j].x * v[r][j].x + v[r][j].y * v[r][j].y) + (v[r][j].z * v[r][j].z + v[r][j].w * v[r][j].w);
        const float rs = 1.0f / sqrtf(wave_sum(s) * (1.f / DM) + EPSN);
#pragma unroll
        for (int j = 0; j < 4; ++j) { const f32x4 o = v[r][j] * rs * gv[j];
            if (OUT32) ((f32x4*)((float*)obase + (size_t)(row0 + r * rstride) * DM))[lane + 64 * j] = o; else ((u32x2*)((bf16_t*)obase + (size_t)(row0 + r * rstride) * DM))[lane + 64 * j] = pack4(o); } }
}

__device__ __forceinline__ float rows_max(float v) {
    u32x2 r = __builtin_amdgcn_permlane16_swap(__float_as_uint(v), __float_as_uint(v), false, false); v = fmaxf(__uint_as_float(r.x), __uint_as_float(r.y));
    r = __builtin_amdgcn_permlane32_swap(__float_as_uint(v), __float_as_uint(v), false, false); return fmaxf(__uint_as_float(r.x), __uint_as_float(r.y));
}
__device__ __forceinline__ unsigned wave_umax(unsigned v) {
    unsigned t;
    t = (unsigned)__builtin_amdgcn_mov_dpp((int)v, 0xB1, 0xF, 0xF, true); v = t > v ? t : v;
    t = (unsigned)__builtin_amdgcn_mov_dpp((int)v, 0x4E, 0xF, 0xF, true); v = t > v ? t : v;
    t = (unsigned)__builtin_amdgcn_mov_dpp((int)v, 0x141, 0xF, 0xF, true); v = t > v ? t : v;
    t = (unsigned)__builtin_amdgcn_mov_dpp((int)v, 0x140, 0xF, 0xF, true); v = t > v ? t : v;
    u32x2 r = __builtin_amdgcn_permlane16_swap(v, v, false, false); v = r.x > r.y ? r.x : r.y;
    r = __builtin_amdgcn_permlane32_swap(v, v, false, false); return r.x > r.y ? r.x : r.y;
}
__device__ __forceinline__ float rows_sum(float v) {
    u32x2 r = __builtin_amdgcn_permlane16_swap(__float_as_uint(v), __float_as_uint(v), false, false); v = __uint_as_float(r.x) + __uint_as_float(r.y);
    r = __builtin_amdgcn_permlane32_swap(__float_as_uint(v), __float_as_uint(v), false, false); return __uint_as_float(r.x) + __uint_as_float(r.y);
}
constexpr int A_KB = 0, A_VB = 18432, A_IMP = 36864, A_SEL = 104448;
struct AttnP { const bf16_t *q, *kcomp, *vcompT, *ks, *kw, *VT; const float* gates; float* scratch; float* scratch2; bf16_t* onsa; };

template <int MODE>
__device__ __forceinline__ void attn_tile(const LAS unsigned char* Ks, const LAS unsigned char* Vs, const bf16x8 (&qf)[4][2], f32x4 (&O)[4][4], float (&m)[4], float (&l)[4], const float (&invl)[4],
                                          int mmode  , bool track, bool lane_valid, int kbase, int kmax, int kmin, LAS float* imp_row, float& carry, int fr, int fq, int lane) {
    const bool masked = (mmode == 2);
#pragma unroll 1
    for (int ks = 0; ks < 2; ++ks) {
        bf16x8 kf[2][2];
#pragma unroll
        for (int sub = 0; sub < 2; ++sub)
#pragma unroll
            for (int ch = 0; ch < 2; ++ch) kf[sub][ch] = *(const LAS bf16x8*)(Ks + (ks * 32 + sub * 16 + fr) * 144 + ch * 64 + fq * 16);
        f32x4 s[4][2];
#pragma unroll
        for (int hh = 0; hh < 4; ++hh)
#pragma unroll
            for (int sub = 0; sub < 2; ++sub) { f32x4 a = {0.f, 0.f, 0.f, 0.f};
                a = __builtin_amdgcn_mfma_f32_16x16x32_bf16(kf[sub][0], qf[hh][0], a, 0, 0, 0);
                a = __builtin_amdgcn_mfma_f32_16x16x32_bf16(kf[sub][1], qf[hh][1], a, 0, 0, 0); s[hh][sub] = a; }
        if (masked) {
#pragma unroll
            for (int sub = 0; sub < 2; ++sub)
#pragma unroll
                for (int i = 0; i < 4; ++i) { const int kidx = kbase + ks * 32 + sub * 16 + 4 * fq + i; const bool v = lane_valid && kidx <= kmax && kidx > kmin;
#pragma unroll
                    for (int hh = 0; hh < 4; ++hh) s[hh][sub][i] = v ? s[hh][sub][i] : -1e30f; }
        }
        bf16x8 pf[4];
        float ps[2][4] = {{0.f, 0.f, 0.f, 0.f}, {0.f, 0.f, 0.f, 0.f}};
#pragma unroll
        for (int hh = 0; hh < 4; ++hh) {
            f32x4 p0, p1;
            if (MODE != 2) {
                float mn = m[hh], alpha = 1.0f;
                if (track) {
                    float mx = fmaxf(fmaxf(fmaxf(s[hh][0][0], s[hh][0][1]), fmaxf(s[hh][0][2], s[hh][0][3])), fmaxf(fmaxf(s[hh][1][0], s[hh][1][1]), fmaxf(s[hh][1][2], s[hh][1][3])));
                    mx = rows_max(mx);
                    if (mmode == 1) mx = lane_valid ? mx : -1e30f;
                    mn = fmaxf(m[hh], mx); alpha = __builtin_amdgcn_exp2f(m[hh] - mn);
                    m[hh] = mn;
                }
#pragma unroll
                for (int i = 0; i < 4; ++i) { p0[i] = __builtin_amdgcn_exp2f(s[hh][0][i] - mn); p1[i] = __builtin_amdgcn_exp2f(s[hh][1][i] - mn); }
                if (masked) {
#pragma unroll
                    for (int i = 0; i < 4; ++i) { p0[i] = s[hh][0][i] < -1e29f ? 0.f : p0[i]; p1[i] = s[hh][1][i] < -1e29f ? 0.f : p1[i]; }
                }
                if (mmode == 1) { const f32x4 z = {0.f, 0.f, 0.f, 0.f}; p0 = lane_valid ? p0 : z; p1 = lane_valid ? p1 : z; }
                l[hh] = l[hh] * alpha + ((p0[0] + p0[1]) + (p0[2] + p0[3])) + ((p1[0] + p1[1]) + (p1[2] + p1[3]));
                if (MODE == 1 && track) { if (__builtin_amdgcn_ballot_w64(alpha != 1.0f) != 0ull) {
#pragma unroll
                    for (int dt = 0; dt < 4; ++dt) O[hh][dt] = O[hh][dt] * alpha; } }
            } else {
                const float mh = m[hh], il = invl[hh];
#pragma unroll
                for (int i = 0; i < 4; ++i) { p0[i] = __builtin_amdgcn_exp2f(s[hh][0][i] - mh) * il; p1[i] = __builtin_amdgcn_exp2f(s[hh][1][i] - mh) * il; }
                if (masked) {
#pragma unroll
                    for (int i = 0; i < 4; ++i) { p0[i] = s[hh][0][i] < -1e29f ? 0.f : p0[i]; p1[i] = s[hh][1][i] < -1e29f ? 0.f : p1[i]; }
                }
#pragma unroll
                for (int i = 0; i < 4; ++i) { ps[0][i] += p0[i]; ps[1][i] += p1[i]; }
            }
            if (MODE != 0) { const u32x4 w = pack8(p0, p1); pf[hh] = __builtin_bit_cast(bf16x8, w); }
        }
        if (MODE == 2) {
            const float a0 = ps[0][0] + ps[0][1] + ps[0][2] + 0.5f * ps[0][3], b0 = 0.5f * ps[0][3];
            const float a1 = ps[1][0] + ps[1][1] + ps[1][2] + 0.5f * ps[1][3], b1 = 0.5f * ps[1][3];
            const int src = (lane - 16) & 63;
            const float x0 = __shfl(b0, src), x1 = __shfl(b1, src);
            const int sa = (kbase + ks * 32) / 4 + fq;
            imp_row[sa] = a0 + (fq > 0 ? x0 : carry);
            imp_row[sa + 4] = a1 + (fq > 0 ? x1 : x0);
            carry = x1;
        }
        if (MODE != 0) {
#pragma unroll
            for (int dt = 0; dt < 4; ++dt) {
                const u32x2 v0 = *(const LAS u32x2*)(Vs + (dt * 16 + fr) * 144 + ks * 64 + fq * 8), v1 = *(const LAS u32x2*)(Vs + (dt * 16 + fr) * 144 + ks * 64 + 32 + fq * 8);
                const u32x4 vv = {v0.x, v0.y, v1.x, v1.y}; const bf16x8 vf = __builtin_bit_cast(bf16x8, vv);
#pragma unroll
                for (int hh = 0; hh < 4; ++hh) O[hh][dt] = __builtin_amdgcn_mfma_f32_16x16x32_bf16(vf, pf[hh], O[hh][dt], 0, 0, 0);
            }
        }
    }
}

template <int BR>
__device__ __forceinline__ void run_branch(LAS unsigned char* lds, const bf16_t* Kg, const bf16_t* Vg, int ldv, int jlo, int jhi, const bf16x8 (&qf)[4][2], f32x4 (&O)[4][4], float (&m)[4], float (&l)[4],
                                           const float (&invl)[4], int tid, int w, int lane, int fr, int fq, int qlo, int tq, int blkq, unsigned long long sel_lo, unsigned long long sel_hi) {
    constexpr int MODE = (BR == 0) ? 0 : (BR == 1 ? 2 : 1);
    const int lrow = tid >> 3, lch = tid & 7;
    u32x4 kr, vr;
#define A_GLOAD(j) do { kr = *(const u32x4*)(Kg + (size_t)(64 * (j) + lrow) * 64 + lch * 8); vr = *(const u32x4*)(Vg + (size_t)lrow * ldv + 64 * (j) + lch * 8); } while (0)
#define A_LSTORE(buf) do { *(LAS u32x4*)(lds + A_KB + (buf) * 9216 + lrow * 144 + lch * 16) = kr; *(LAS u32x4*)(lds + A_VB + (buf) * 9216 + lrow * 144 + lch * 16) = vr; } while (0)
    A_GLOAD(jlo); A_LSTORE(0); __syncthreads();
    float carry = 0.f;
    LAS float* imp_row = (LAS float*)(lds + A_IMP) + (w * 16 + fr) * 132;
    for (int j = jlo; j <= jhi; ++j) {
        const int cur = (j - jlo) & 1;
        if (j < jhi) A_GLOAD(j + 1);
        bool skip = false, masked = false, lane_valid = true; int kmax = 0x7fffffff, kmin = -1;
        if (BR <= 1) { const int lim_lo = (qlo - 31) >> 4, lim_hi = (qlo + 15 - 31) >> 4; kmax = (tq - 31) >> 4; masked = (64 * j + 63 > lim_lo); skip = (BR == 0) && (64 * j > lim_hi); }
        if (BR == 2) { lane_valid = (((j < 64 ? sel_lo : sel_hi) >> (j & 63)) & 1ull) != 0ull; const unsigned long long bal = __builtin_amdgcn_ballot_w64(lane_valid);
            skip = (j > blkq) || (bal == 0ull); masked = (j == blkq) || (bal != ~0ull); kmax = (j == blkq) ? tq : 0x7fffffff; }
        if (BR == 3) { skip = (64 * j > qlo + 15) || (64 * j + 63 <= qlo - 512); masked = (64 * j + 63 > qlo) || (64 * j <= qlo + 15 - 512); kmax = tq; kmin = tq - 512; }
        int mmode = masked ? 2 : 0;
        const bool track = (MODE == 2) || (__builtin_amdgcn_ballot_w64(m[0] < -1e29f) != 0ull);
        if (BR == 2) mmode = (j == blkq) ? 2 : (masked ? 1 : 0);
        if (!skip) attn_tile<MODE>(lds + A_KB + cur * 9216, lds + A_VB + cur * 9216, qf, O, m, l, invl, mmode, track, lane_valid, 64 * j, kmax, kmin, imp_row, carry, fr, fq, lane);
        if (j < jhi) A_LSTORE(cur ^ 1);
        __syncthreads();
    }
#undef A_GLOAD
#undef A_LSTORE
}


__device__ __forceinline__ void run_branch_sel(LAS unsigned char* lds, const bf16_t* Kg, const bf16_t* Vg, int ldv, int jhi, const bf16_t* qbase  ,
                                               const float* gbase  , bf16_t* obase  ,
                                               int tid, int w, int lane, int fr, int fq, int qlo, int blkq) {
    const int lrow = tid >> 3, lch = tid & 7;
    const int ql = fr >> 2, hl = fr & 3;
    bf16x8 qf[4][2]; f32x4 O[4][4]; float m[4], l[4];
#pragma unroll
    for (int gi = 0; gi < 4; ++gi) { m[gi] = -1e30f; l[gi] = 0.f;
#pragma unroll
        for (int ch = 0; ch < 2; ++ch) qf[gi][ch] = *(const bf16x8*)(qbase + (size_t)(gi * 4 + ql) * 512 + hl * 64 + ch * 32 + fq * 8);
#pragma unroll
        for (int dt = 0; dt < 4; ++dt) O[gi][dt] = (f32x4){0.f, 0.f, 0.f, 0.f}; }
    const LAS unsigned* selw = (const LAS unsigned*)(lds + A_SEL) + (w * 16 + ql) * 4;
    u32x4 kr, vr;
#define S_GLOAD(j) do { kr = *(const u32x4*)(Kg + (size_t)(64 * (j) + lrow) * 64 + lch * 8); vr = *(const u32x4*)(Vg + (size_t)lrow * ldv + 64 * (j) + lch * 8); } while (0)
#define S_LSTORE(buf) do { *(LAS u32x4*)(lds + A_KB + (buf) * 9216 + lrow * 144 + lch * 16) = kr; *(LAS u32x4*)(lds + A_VB + (buf) * 9216 + lrow * 144 + lch * 16) = vr; } while (0)
    S_GLOAD(0); S_LSTORE(0); __syncthreads();
    for (int j = 0; j <= jhi; ++j) {
        const int cur = j & 1;
        if (j < jhi) S_GLOAD(j + 1);
        if (j <= blkq) {
            const LAS unsigned char* Ks = lds + A_KB + cur * 9216; const LAS unsigned char* Vs = lds + A_VB + cur * 9216;
            bool lv[4]; unsigned long long bal[4]; bool anyg = false;
#pragma unroll
            for (int gi = 0; gi < 4; ++gi) { lv[gi] = ((selw[gi * 16 + (j >> 5)] >> (j & 31)) & 1u) != 0u; bal[gi] = __builtin_amdgcn_ballot_w64(lv[gi]); anyg = anyg || (bal[gi] != 0ull); }
            if (anyg) {
#pragma unroll
                for (int ks = 0; ks < 2; ++ks) {
                    bf16x8 kf[2][2], vf[4];
#pragma unroll
                    for (int sub = 0; sub < 2; ++sub)
#pragma unroll
                        for (int ch = 0; ch < 2; ++ch) kf[sub][ch] = *(const LAS bf16x8*)(Ks + (ks * 32 + sub * 16 + fr) * 144 + ch * 64 + fq * 16);
#pragma unroll
                    for (int dt = 0; dt < 4; ++dt) { const u32x2 v0 = *(const LAS u32x2*)(Vs + (dt * 16 + fr) * 144 + ks * 64 + fq * 8), v1 = *(const LAS u32x2*)(Vs + (dt * 16 + fr) * 144 + ks * 64 + 32 + fq * 8);
                        const u32x4 vv = {v0.x, v0.y, v1.x, v1.y}; vf[dt] = __builtin_bit_cast(bf16x8, vv); }
#pragma unroll
                    for (int gi = 0; gi < 4; ++gi) {
                        if (bal[gi] != 0ull) {
                            f32x4 s0 = {0.f, 0.f, 0.f, 0.f}, s1 = {0.f, 0.f, 0.f, 0.f};
                            s0 = __builtin_amdgcn_mfma_f32_16x16x32_bf16(kf[0][0], qf[gi][0], s0, 0, 0, 0); s0 = __builtin_amdgcn_mfma_f32_16x16x32_bf16(kf[0][1], qf[gi][1], s0, 0, 0, 0);
                            s1 = __builtin_amdgcn_mfma_f32_16x16x32_bf16(kf[1][0], qf[gi][0], s1, 0, 0, 0); s1 = __builtin_amdgcn_mfma_f32_16x16x32_bf16(kf[1][1], qf[gi][1], s1, 0, 0, 0);
                            const bool alllv = (bal[gi] == ~0ull);
                            if (j == blkq) {
                                const int tqg = qlo + gi * 4 + ql;
#pragma unroll
                                for (int i = 0; i < 4; ++i) { const int k0 = 64 * j + ks * 32 + 4 * fq + i; s0[i] = (k0 <= tqg) ? s0[i] : -1e30f; s1[i] = (k0 + 16 <= tqg) ? s1[i] : -1e30f; }
                            }
                            float mn = m[gi], alpha = 1.0f;
                            const bool track = __builtin_amdgcn_ballot_w64(m[gi] < -1e29f) != 0ull;
                            if (track) {
                                float mx = fmaxf(fmaxf(fmaxf(s0[0], s0[1]), fmaxf(s0[2], s0[3])), fmaxf(fmaxf(s1[0], s1[1]), fmaxf(s1[2], s1[3])));
                                mx = rows_max(mx); mx = lv[gi] ? mx : -1e30f;
                                mn = fmaxf(m[gi], mx); alpha = __builtin_amdgcn_exp2f(m[gi] - mn); m[gi] = mn;
                            }
                            f32x4 p0, p1;
#pragma unroll
                            for (int i = 0; i < 4; ++i) { p0[i] = __builtin_amdgcn_exp2f(s0[i] - mn); p1[i] = __builtin_amdgcn_exp2f(s1[i] - mn); }
                            if (j == blkq) {
#pragma unroll
                                for (int i = 0; i < 4; ++i) { p0[i] = s0[i] < -1e29f ? 0.f : p0[i]; p1[i] = s1[i] < -1e29f ? 0.f : p1[i]; }
                            }
                            if (!alllv) { const f32x4 z = {0.f, 0.f, 0.f, 0.f}; p0 = lv[gi] ? p0 : z; p1 = lv[gi] ? p1 : z; }
                            l[gi] = l[gi] * alpha + ((p0[0] + p0[1]) + (p0[2] + p0[3])) + ((p1[0] + p1[1]) + (p1[2] + p1[3]));
                            if (track) { if (__builtin_amdgcn_ballot_w64(alpha != 1.0f) != 0ull) {
#pragma unroll
                                for (int dt = 0; dt < 4; ++dt) O[gi][dt] = O[gi][dt] * alpha; } }
                            const u32x4 pw = pack8(p0, p1); const bf16x8 pf = __builtin_bit_cast(bf16x8, pw);
#pragma unroll
                            for (int dt = 0; dt < 4; ++dt) O[gi][dt] = __builtin_amdgcn_mfma_f32_16x16x32_bf16(vf[dt], pf, O[gi][dt], 0, 0, 0);
                        }
                    }
                }
            }
        }
        if (j < jhi) S_LSTORE(cur ^ 1);
        __syncthreads();
    }
#undef S_GLOAD
#undef S_LSTORE
#pragma unroll
    for (int gi = 0; gi < 4; ++gi) { const float lt = rows_sum(l[gi]); const float gt = lt > 0.f ? gbase[(size_t)(gi * 4 + ql) * 24 + hl * 3 + 1] / lt : 0.f;
        bf16_t* op = obase + (size_t)(gi * 4 + ql) * 512 + hl * 64 + 4 * fq;
#pragma unroll
        for (int dt = 0; dt < 4; ++dt) *(u32x2*)(op + dt * 16) = pack4(O[gi][dt] * gt); }
}

__device__ __forceinline__ void attn_unit(LAS unsigned char* lds, const AttnP& P, int b, int g, int iu, int tid, int w, int lane) {
    const int fr = lane & 15, fq = lane >> 4;
    const int t0 = iu * 128, qlo = t0 + 16 * w, tq = qlo + fr, blkq = qlo >> 6;
    const size_t rowq = (size_t)b * SEQ + tq;
#define A_STATE() bf16x8 qf[4][2]; f32x4 O[4][4]; float m[4], l[4], invl[4]; \
    _Pragma("unroll") for (int hh = 0; hh < 4; ++hh) _Pragma("unroll") for (int ch = 0; ch < 2; ++ch) qf[hh][ch] = *(const bf16x8*)(P.q + rowq * 512 + (g * 4 + hh) * 64 + ch * 32 + fq * 8)
#define A_RESET() do { _Pragma("unroll") for (int hh = 0; hh < 4; ++hh) { m[hh] = -1e30f; l[hh] = 0.f; invl[hh] = 0.f; _Pragma("unroll") for (int dt = 0; dt < 4; ++dt) O[hh][dt] = (f32x4){0.f, 0.f, 0.f, 0.f}; } } while (0)
#define A_FINL() do { _Pragma("unroll") for (int hh = 0; hh < 4; ++hh) { float lt = rows_sum(l[hh]); invl[hh] = lt > 0.f ? 1.0f / lt : 0.f; } } while (0)
    const int bg = b * 2 + g;
#define A_PTRS() size_t rq_ = rowq; asm volatile("" : "+v"(rq_)); float* scr = P.scratch + rq_ * 512 + g * 256 + 4 * fq; const float* gp = P.gates + rq_ * 24 + g * 12
    { A_STATE();
    {
        const bf16_t* Kc = P.kcomp + (size_t)(bg * 512) * 64; const bf16_t* Vc = P.vcompT + bg * 512;
        const int ntc = (8 * iu + 7 + 63) >> 6;
        A_RESET();
        run_branch<0>(lds, Kc, Vc, 4096, 0, ntc - 1, qf, O, m, l, invl, tid, w, lane, fr, fq, qlo, tq, blkq, 0ull, 0ull);
        A_FINL();
        run_branch<1>(lds, Kc, Vc, 4096, 0, ntc - 1, qf, O, m, l, invl, tid, w, lane, fr, fq, qlo, tq, blkq, 0ull, 0ull);
    }
    {
        LAS float* impw = (LAS float*)(lds + A_IMP) + (w * 16) * 132;
        LAS unsigned* sel = (LAS unsigned*)(lds + A_SEL) + (w * 16) * 4;
        for (int qi = 0; qi < 8; ++qi) {
            unsigned long long loA, hiA = 0ull, loB, hiB = 0ull;
            if (blkq + 1 <= 16) { loA = (2ull << blkq) - 1ull; loB = loA; }
            else {
                loA = 1ull;
                { const int s1 = blkq - 1, s2 = blkq; if (s1 < 64) loA |= 1ull << s1; else hiA |= 1ull << (s1 - 64); if (s2 < 64) loA |= 1ull << s2; else hiA |= 1ull << (s2 - 64); }
                loB = loA; hiB = hiA;
                const float a0 = impw[qi * 132 + lane], a1 = impw[qi * 132 + 64 + lane], b0 = impw[(qi + 8) * 132 + lane], b1 = impw[(qi + 8) * 132 + 64 + lane];
                const bool c0 = (lane >= 1 && lane <= blkq - 2), c1 = (lane + 64 <= blkq - 2);
                unsigned ka0 = c0 ? ((__float_as_uint(a0) & ~127u) | (unsigned)(127 - lane)) : 0u, ka1 = c1 ? ((__float_as_uint(a1) & ~127u) | (unsigned)(63 - lane)) : 0u;
                unsigned kb0 = c0 ? ((__float_as_uint(b0) & ~127u) | (unsigned)(127 - lane)) : 0u, kb1 = c1 ? ((__float_as_uint(b1) & ~127u) | (unsigned)(63 - lane)) : 0u;
                for (int r = 0; r < 13; ++r) {
                    unsigned bestA = ka0 > ka1 ? ka0 : ka1, bestB = kb0 > kb1 ? kb0 : kb1;
                    bestA = wave_umax(bestA); bestB = wave_umax(bestB);
                    bestA = (unsigned)__builtin_amdgcn_readfirstlane((int)bestA); bestB = (unsigned)__builtin_amdgcn_readfirstlane((int)bestB);
                    const int sA = 127 - (int)(bestA & 127u), sB = 127 - (int)(bestB & 127u);
                    if (sA < 64) loA |= 1ull << sA; else hiA |= 1ull << (sA - 64);
                    if (sB < 64) loB |= 1ull << sB; else hiB |= 1ull << (sB - 64);
                    if (ka0 == bestA) ka0 = 0u; if (ka1 == bestA) ka1 = 0u; if (kb0 == bestB) kb0 = 0u; if (kb1 == bestB) kb1 = 0u;
                }
            }
            if (lane == 0) { sel[qi * 4 + 0] = (unsigned)loA; sel[qi * 4 + 1] = (unsigned)(loA >> 32); sel[qi * 4 + 2] = (unsigned)hiA; sel[qi * 4 + 3] = (unsigned)(hiA >> 32);
                             sel[(qi + 8) * 4 + 0] = (unsigned)loB; sel[(qi + 8) * 4 + 1] = (unsigned)(loB >> 32); sel[(qi + 8) * 4 + 2] = (unsigned)hiB; sel[(qi + 8) * 4 + 3] = (unsigned)(hiB >> 32); }
        }
    }
    { A_PTRS();
#pragma unroll
    for (int hh = 0; hh < 4; ++hh) { const float gt = gp[hh * 3 + 0];
#pragma unroll
        for (int dt = 0; dt < 4; ++dt) *(f32x4*)(scr + hh * 64 + dt * 16) = O[hh][dt] * gt; } }
    }
    {
        const bf16_t* Kg = P.ks + (size_t)(bg * SEQ) * 64; const bf16_t* Vg = P.VT + (size_t)(g * 64) * T + (size_t)b * SEQ;
        const size_t r0 = (size_t)b * SEQ + qlo;
        run_branch_sel(lds, Kg, Vg, T, 2 * iu + 1, P.q + r0 * 512 + g * 256, P.gates + r0 * 24 + g * 12, P.onsa + r0 * 512 + g * 256, tid, w, lane, fr, fq, qlo, blkq);
    }
    {
        A_STATE();
        const bf16_t* Kg = P.kw + (size_t)(bg * SEQ) * 64; const bf16_t* Vg = P.VT + (size_t)(128 + g * 64) * T + (size_t)b * SEQ;
        A_RESET();
        const int jlo = 2 * iu - 8 < 0 ? 0 : 2 * iu - 8;
        run_branch<3>(lds, Kg, Vg, T, jlo, 2 * iu + 1, qf, O, m, l, invl, tid, w, lane, fr, fq, qlo, tq, blkq, 0ull, 0ull);
        A_FINL();
        A_PTRS(); bf16_t* op = P.onsa + rq_ * 512 + g * 256 + 4 * fq;
#pragma unroll
        for (int hh = 0; hh < 4; ++hh) { const float gt = gp[hh * 3 + 2] * invl[hh];
#pragma unroll
            for (int dt = 0; dt < 4; ++dt) { const u32x2 pk_ = *(const u32x2*)(op + hh * 64 + dt * 16); const f32x4 sel_ = {bf_lo(pk_.x), bf_hi(pk_.x), bf_lo(pk_.y), bf_hi(pk_.y)};
                const f32x4 r = *(const f32x4*)(scr + hh * 64 + dt * 16) + sel_ + O[hh][dt] * gt; *(u32x2*)(op + hh * 64 + dt * 16) = pack4(r); } }
    }
#undef A_STATE
#undef A_PTRS
#undef A_RESET
#undef A_FINL
}

#define XB_TMO      128
#define XB_XCNT(j)  (256  + 64 * (j))
#define XB_XSUB(j)  (1280 + 64 * (j))
#define XB_XGEN(j)  (2304 + 64 * (j))
#define XB_TOP      3328
#define XB_TOPGEN   3392
#define XCD_BAR_WORDS 3456
#define XB_SPIN_CAP (1u << 18)

__device__ __forceinline__ unsigned xb_ld(unsigned* p)              { return __hip_atomic_load(p, __ATOMIC_RELAXED, __HIP_MEMORY_SCOPE_AGENT); }
__device__ __forceinline__ unsigned xb_add(unsigned* p, unsigned v) { return __hip_atomic_fetch_add(p, v, __ATOMIC_RELAXED, __HIP_MEMORY_SCOPE_AGENT); }
__device__ __forceinline__ unsigned xb_xcc_id() { return (unsigned)__builtin_amdgcn_s_getreg((3 << 11) | 20) & 0xFu; }
#define XB_SPIN(cond, bar) do { unsigned _sp = 0; while (cond) { __builtin_amdgcn_s_sleep(1); \
    if ((++_sp & 255u) == 0u) { if (xb_ld(&(bar)[XB_TMO])) break; if (_sp > XB_SPIN_CAP) { atomicAdd(&(bar)[XB_TMO], 1u); break; } } } } while (0)

struct XcdBarrier {
    unsigned* bar; unsigned x;
    volatile LAS unsigned* st;
};

__device__ __forceinline__ XcdBarrier xcd_barrier_post(unsigned* bar, volatile LAS unsigned* st) {
    XcdBarrier b; b.bar = bar; b.x = xb_xcc_id(); b.st = st;
    if (threadIdx.x == 0) (void)xb_add(&bar[XB_XCNT(b.x)], 1u);
    return b;
}
__device__ __forceinline__ void xcd_barrier_complete(unsigned* bar, unsigned x, unsigned& nloc, unsigned& nx) {
    const unsigned G = gridDim.x * gridDim.y * gridDim.z;
    unsigned sum, cnt, mine, sp = 0u;
    for (;;) {
        sum = 0u; cnt = 0u; mine = 0u;
#pragma unroll
        for (unsigned j = 0; j < 16; ++j) { const unsigned c = xb_ld(&bar[XB_XCNT(j)]); sum += c; cnt += (c > 0u) ? 1u : 0u; mine = (j == x) ? c : mine; }
        if (sum == G) break;
        __builtin_amdgcn_s_sleep(1);
        if ((++sp & 255u) == 0u) { if (xb_ld(&bar[XB_TMO])) break; if (sp > XB_SPIN_CAP) { atomicAdd(&bar[XB_TMO], 1u); break; } }
    }
    nloc = mine > 0u ? mine : 1u; nx = cnt > 0u ? cnt : 1u;
}

__device__ __forceinline__ void xcd_barrier(const XcdBarrier& b) {
    asm volatile("s_waitcnt vmcnt(0)" ::: "memory");
    __syncthreads();
    if (threadIdx.x == 0) {
        unsigned* bar = b.bar;
        __builtin_amdgcn_s_waitcnt(0);
        unsigned nloc = b.st[0], nx = b.st[1];
        if (nloc == 0u) { xcd_barrier_complete(bar, b.x, nloc, nx); b.st[0] = nloc; b.st[1] = nx; }
        const unsigned old = xb_add(&bar[XB_XSUB(b.x)], 1u);
        const unsigned gen = old / nloc;
        if (old + 1u == (gen + 1u) * nloc) {
            __builtin_amdgcn_fence(__ATOMIC_RELEASE, "agent");
            asm volatile("s_waitcnt vmcnt(0)" ::: "memory");
            const unsigned og = xb_add(&bar[XB_TOP], 1u);
            const unsigned tg = og / nx;
            if (og + 1u == (tg + 1u) * nx) xb_add(&bar[XB_TOPGEN], 1u);
            else XB_SPIN(xb_ld(&bar[XB_TOPGEN]) == tg, bar);
            __builtin_amdgcn_fence(__ATOMIC_ACQUIRE, "agent");
            xb_add(&bar[XB_XGEN(b.x)], 1u);
            asm volatile("s_waitcnt vmcnt(0)" ::: "memory");
        } else {
            XB_SPIN(xb_ld(&bar[XB_XGEN(b.x)]) == gen, bar);
            __builtin_amdgcn_fence(__ATOMIC_ACQUIRE, "agent");
            asm volatile("s_waitcnt vmcnt(0)" ::: "memory");
        }
    }
    __syncthreads();
}

struct Args { const void* in[30]; float* out; unsigned char* ws; double invf[32]; int ph_lo, ph_hi; };

enum { PH_PRO = 0, PH_F1UP, PH_F1DN, PH_WIN, PH_WVT, PH_C1K, PH_C2K, PH_C1V, PH_C2V, PH_CONV, PH_PCONV, PH_ATTN, PH_GA, PH_PA, PH_GB, PH_PB, PH_WO, PH_F2UP, PH_F2DN, PH_PP, PH_PG, PH_FNORM, PH_N };
__host__ __device__ inline bool sync_after(int k) { return !(k == PH_WIN || k == PH_C1K || k == PH_C1V || k == PH_C2K || k == PH_C2V || k == PH_CONV || k == PH_GA || k == PH_PA || (k == PH_GB && !(DBG_GATE >= 1 && DBG_GATE <= 4)) || k == PH_PP || k == PH_FNORM); }

__global__ void __launch_bounds__(512, 2) fwd_kernel(Args a) {
    extern __shared__ __attribute__((aligned(16))) unsigned char lds_raw[];
    LAS unsigned char* lds = (LAS unsigned char*)lds_raw;
    const int G = gridDim.x, bid = blockIdx.x, NGW = G * NWAVES;
    unsigned char* ws = a.ws;
    const float* x = (const float*)a.in[0]; const float* pin = (const float*)a.in[1]; const int* positions = (const int*)a.in[2];
    float* H = (float*)(ws + WS_H); bf16_t* U = (bf16_t*)(ws + WS_U); bf16_t* HID = (bf16_t*)(ws + WS_BIG);

#if !SPLIT_LAUNCH
    volatile LAS unsigned* bar_st = (volatile LAS unsigned*)(lds + 139264);
    if (threadIdx.x < 2) bar_st[threadIdx.x] = 0u;
    __syncthreads();
    XcdBarrier xbar = xcd_barrier_post((unsigned*)ws + 1024, bar_st);
#endif
#ifndef REP_PRO_N
#define REP_PRO_N 0
#endif
#ifndef PRO_SKIP_T
#define PRO_SKIP_T 0
#endif
    for (int it_ = a.ph_lo - REP_PRO_N; it_ < a.ph_hi; ++it_) { const int ph = it_ < 0 ? 0 : it_;
        int tid = threadIdx.x; asm volatile("" : "+v"(tid));
        const int lane = tid & 63, wave = __builtin_amdgcn_readfirstlane(tid >> 6), gw = bid * NWAVES + wave;
        Job J; J.A = nullptr; J.Bt = nullptr; J.M = 0; J.N = 0; J.K = 0; J.lda = 0; J.kind = -1; J.rot = 0; J.p0 = nullptr; J.p1 = nullptr; J.p2 = nullptr; J.scale = 1.f;
        switch (ph) {
        case PH_F1UP: J.A = U; J.Bt = (bf16_t*)(ws + WS_F1UP); J.M = T; J.N = 2 * FF; J.K = DM; J.lda = DM; J.kind = K_SWIGLU; J.p0 = HID; break;
        case PH_F1DN: J.A = HID; J.Bt = (bf16_t*)(ws + WS_F1DN); J.M = T; J.N = DM; J.K = FF; J.lda = FF; J.kind = K_RESID; J.p0 = (void*)x; J.p1 = H; J.scale = 0.5f; break;
        case PH_WIN: J.A = U; J.Bt = (bf16_t*)(ws + WS_WIN); J.M = T; J.N = 2816; J.K = DM; J.lda = DM; J.kind = K_WIN; break;
        case PH_WVT: J.A = (bf16_t*)(ws + WS_WVT); J.Bt = U; J.M = 256; J.N = T; J.K = DM; J.lda = DM; J.kind = K_VT; J.rot = 128; J.p0 = ws + WS_VT; break;
        case PH_C1K: J.A = (bf16_t*)(ws + WS_KCR); J.Bt = (bf16_t*)(ws + WS_CK1); J.M = 4096; J.N = 256; J.K = 2048; J.lda = 1024; J.kind = K_GELU; J.p0 = ws + WS_HCK; J.p1 = ws + WS_BIASK; break;
        case PH_C1V: J.A = (bf16_t*)(ws + WS_VCR); J.Bt = (bf16_t*)(ws + WS_CV1); J.M = 4096; J.N = 256; J.K = 2048; J.lda = 1024; J.kind = K_GELU; J.rot = 16; J.p0 = ws + WS_HCV; J.p1 = ws + WS_BIASV; break;
        case PH_C2K: J.A = (bf16_t*)(ws + WS_HCK); J.Bt = (bf16_t*)(ws + WS_CK2); J.M = 4096; J.N = 256; J.K = 256; J.lda = 256; J.kind = K_KC; J.p0 = ws + WS_KCOMP; break;
        case PH_C2V: J.A = (bf16_t*)(ws + WS_CV2); J.Bt = (bf16_t*)(ws + WS_HCV); J.M = 256; J.N = 4096; J.K = 256; J.lda = 256; J.kind = K_VCT; J.rot = 16; J.p0 = ws + WS_VCOMPT; break;
        case PH_GA: J.A = U; J.Bt = (bf16_t*)(ws + WS_WGA); J.M = T; J.N = DM; J.K = DM; J.lda = DM; J.kind = K_SIG; J.p0 = ws + WS_SGA; break;
        case PH_PA: J.A = (bf16_t*)(ws + WS_ONSA); J.Bt = (bf16_t*)(ws + WS_PA); J.M = T; J.N = DM; J.K = 512; J.lda = 512; J.kind = K_PROJA; J.p0 = ws + WS_SGA; break;
        case PH_GB: J.A = U; J.Bt = (bf16_t*)(ws + WS_WGB); J.M = T; J.N = DM; J.K = DM; J.lda = DM; J.kind = K_SIG; J.p0 = ws + WS_SGB; break;
        case PH_PB: J.A = (bf16_t*)(ws + WS_OCONV); J.Bt = (bf16_t*)(ws + WS_PB); J.M = T; J.N = DM; J.K = 512; J.lda = 512; J.kind = K_PROJB; J.p0 = ws + WS_SGB; J.p1 = ws + WS_SGA; break;
        case PH_WO: J.A = (bf16_t*)(ws + WS_SGB); J.Bt = (bf16_t*)(ws + WS_WO); J.M = T; J.N = DM; J.K = DM; J.lda = DM; J.kind = K_RESID; J.p0 = H; J.p1 = H; J.scale = 1.f; break;
        case PH_F2UP: J.A = U; J.Bt = (bf16_t*)(ws + WS_F2UP); J.M = T; J.N = 2 * FF; J.K = DM; J.lda = DM; J.kind = K_SWIGLU; J.p0 = HID; break;
        case PH_F2DN: J.A = HID; J.Bt = (bf16_t*)(ws + WS_F2DN); J.M = T; J.N = DM; J.K = FF; J.lda = FF; J.kind = K_RESID; J.p0 = H; J.p1 = H; J.scale = 0.5f; break;
        case PH_PP: J.A = (bf16_t*)(ws + WS_PBF); J.Bt = (bf16_t*)(ws + WS_PP); J.M = T; J.N = DM; J.K = 256; J.lda = 256; J.kind = K_ST32; J.p0 = ws + WS_TMP; break;
        case PH_PG: J.A = U; J.Bt = (bf16_t*)(ws + WS_PG); J.M = T; J.N = DM; J.K = DM; J.lda = DM; J.kind = K_PLE; J.p0 = H; J.p1 = ws + WS_TMP; break;
        default: break;
        }
        J.rowss = nullptr; J.ssout = nullptr;
        { float* ssq = (float*)(ws + WS_SUMSQ);
          switch (ph) {
          case PH_F1DN: J.p2 = U; J.ssout = ssq; break;
          case PH_WIN: case PH_WVT: case PH_GA: case PH_GB: J.rowss = ssq; break;
          case PH_WO: J.p2 = U; J.ssout = ssq + T; break;
          case PH_F2UP: J.rowss = ssq + T; break;
          case PH_F2DN: J.p2 = U; J.ssout = ssq + 2 * T; break;
          case PH_PG: J.rowss = ssq + 2 * T; break;
          default: break; } }
#if DBG_GATE
        if (ph == PH_PRO && bid == 0 && tid == 0) { *(unsigned*)ws = 0u; ((unsigned*)ws)[1] = 0u; }
#if DBG_GATE == 2
        if (ph == PH_C1K && bid < 4) {
            const int sidx = bid * 512 + tid; const int row = (int)(((long long)sidx * 7919) % T), col = (int)(((long long)sidx * 104729) % 512);
            const float* win = (const float*)a.in[8]; float g = 0.f;
            for (int k = 0; k < DM; ++k) { const float wv = __uint_as_float(f2bf(win[(size_t)k * WIN_COLS + 1304 + col]) << 16); g += __uint_as_float((unsigned)U[(size_t)row * DM + k] << 16) * wv; }
            const float got = __uint_as_float((unsigned)((const bf16_t*)(ws + WS_CB))[(size_t)row * 512 + col] << 16);
            if (!(fabsf(g - got) < 0.03f + 0.01f * fabsf(g))) { atomicOr((unsigned*)ws, 1u); atomicAdd((unsigned*)ws + 1, 1u); }
        }
#endif
#if DBG_GATE == 5
        if (ph == PH_WO && bid < 4) {
            const int sidx = bid * 512 + tid; const int row = (int)(((long long)sidx * 7919) % T), col = (int)(((long long)sidx * 104729) % 1024);
            const float* win = (const float*)a.in[8]; const float* wb = (const float*)a.in[20]; float g = 0.f, v = 0.f;
            for (int k = 0; k < DM; ++k) { const float wv = __uint_as_float(f2bf(win[(size_t)k * WIN_COLS + 3864 + col]) << 16); g += __uint_as_float((unsigned)U[(size_t)row * DM + k] << 16) * wv; }
            const bf16_t* oc = (const bf16_t*)(ws + WS_OCONV);
            for (int k = 0; k < 512; ++k) { const float wv = __uint_as_float(f2bf(wb[(size_t)k * DM + col]) << 16); v += __uint_as_float((unsigned)oc[(size_t)row * 512 + k] << 16) * wv; }
            const float ref = v / (1.0f + expf(-g)); const float got = __uint_as_float((unsigned)((const bf16_t*)(ws + WS_SGB))[(size_t)row * DM + col] << 16);
            if (DBG_STRAT) { atomicOr((unsigned*)ws, 1u); if (!(fabsf(ref - got) < 0.03f + 0.02f * fabsf(ref))) atomicAdd((unsigned*)ws + 1, 1u); }
        }
#endif
#if DBG_GATE == 3
        if (ph == PH_GA && bid < 4) {
            const int sidx = bid * 512 + tid; const int row = (int)(((long long)sidx * 7919) % T), col = (int)(((long long)sidx * 104729) % 1024);
            float ss = 0.f; for (int k = 0; k < DM; ++k) { const float hv = H[(size_t)row * DM + k]; ss += hv * hv; }
            const float ref = H[(size_t)row * DM + col] * (1.0f / sqrtf(ss * (1.f / DM) + EPSN)) * ((const float*)a.in[7])[col];
            const float got = __uint_as_float((unsigned)U[(size_t)row * DM + col] << 16);
            if (!(fabsf(ref - got) < 0.02f + 0.01f * fabsf(ref))) { atomicOr((unsigned*)ws, 1u); atomicAdd((unsigned*)ws + 1, 1u); }
        }
#endif
        if ((DBG_GATE == 1 || DBG_GATE == 4) && ph == PH_PB) J.kind = -2;
        if ((DBG_GATE == 1 || DBG_GATE == 4) && ph == PH_PB && bid < 4) {
            const int sidx = bid * 512 + tid; const int row = (int)(((long long)sidx * 7919) % T), col = (int)(((long long)sidx * 104729) % 1024);
            const float* win = (const float*)a.in[8]; float g = 0.f;
            for (int k = 0; k < DM; ++k) { const float wv = __uint_as_float(f2bf(win[(size_t)k * WIN_COLS + 3864 + col]) << 16); g += __uint_as_float((unsigned)U[(size_t)row * DM + k] << 16) * wv; }
            const float ref = 1.0f / (1.0f + expf(-g)); const float got = __uint_as_float((unsigned)((const bf16_t*)(ws + WS_SGB))[(size_t)row * DM + col] << 16);
#if DBG_GATE == 4
            if (fabsf(g) > 3.0f) { atomicOr((unsigned*)ws, 1u); atomicAdd((unsigned*)ws + 1, 1u); }
#else
            if (DBG_STRAT) { atomicOr((unsigned*)ws, 1u); if (!(fabsf(ref - got) < 0.03f)) atomicAdd((unsigned*)ws + 1, 1u); }
#endif
            { const bf16_t* wt = (const bf16_t*)(ws + WS_WGB); bool bad = false;
              for (int k = 0; k < DM; k += 37) { if (wt[(size_t)col * DM + k] != (bf16_t)f2bf(win[(size_t)k * WIN_COLS + 3864 + col])) bad = true; }
              if (bad) atomicOr((unsigned*)ws, 2u); }
        }
        if (ph == PH_FNORM) { if (*(volatile unsigned*)ws != 0u) { for (int row = gw; row < T; row += NGW) for (int j = 0; j < 4; ++j) { const float fv = (*(volatile unsigned*)ws & 2u) ? 100.f : 1.0f + 9.0f * (float)((volatile unsigned*)ws)[1] / 2048.0f; ((f32x4*)(a.out + (size_t)row * DM))[lane + 64 * j] = (f32x4){fv, fv, fv, fv}; } continue; } }
#endif
#ifdef SKIP_PH
        if (((SKIP_PH) >> ph) & 1) J.kind = -2;
#endif
        if (J.kind >= 0) {
            EpiSwitch E; E.J = J;
            E.W.ws = ws; E.W.sg = nullptr;
            pg8::Gemm g{J.A, J.Bt, J.M, J.N, J.K, J.lda}; pg8::StaticOrder S; S.init(J.M, J.N, G, (bid + J.rot) % G);
#ifndef NO_GEMM
            pg8::gemm_phase<EpiSwitch, pg8::StaticOrder, GP_ALIGN, GP_SP2>(lds, g, S, E);
#endif
#ifdef REP_PH
            if (ph == REP_PH) pg8::gemm_phase<EpiSwitch, pg8::StaticOrder, GP_ALIGN, GP_SP2>(lds, g, S, E);
#endif
        } else if (ph == PH_PRO) {
            LAS float* scr = (LAS float*)(lds + wave * 17024);
            int base = 0;
#pragma unroll
            for (int jb = 0; jb < 17; ++jb) {
                const float* W0 = nullptr; const float* W1 = nullptr; const float* gn = nullptr; int K = 0, N = 0, P = 0, pk = PK_ID; size_t dst = 0;
                switch (jb) {
                case 0: W0 = (const float*)a.in[4]; W1 = (const float*)a.in[5]; K = DM; N = FF; P = 2 * FF; pk = PK_SWIGLU; dst = WS_F1UP; break;
                case 1: W0 = (const float*)a.in[6]; K = FF; N = DM; P = DM; dst = WS_F1DN; break;
                case 2: gn = (const float*)a.in[22]; W0 = (const float*)a.in[23]; W1 = (const float*)a.in[24]; K = DM; N = FF; P = 2 * FF; pk = PK_SWIGLU; dst = WS_F2UP; break;
                case 3: W0 = (const float*)a.in[25]; K = FF; N = DM; P = DM; dst = WS_F2DN; break;
                case 4: gn = (const float*)a.in[7]; W0 = (const float*)a.in[8]; K = DM; N = WIN_COLS; P = 2816; pk = PK_WIN; dst = WS_WIN; break;
                case 15: gn = (const float*)a.in[7]; W0 = (const float*)a.in[8]; K = DM; N = WIN_COLS; P = DM; pk = PK_GA; dst = WS_WGA; break;
                case 16: gn = (const float*)a.in[7]; W0 = (const float*)a.in[8]; K = DM; N = WIN_COLS; P = DM; pk = PK_GB; dst = WS_WGB; break;
                case 5: gn = (const float*)a.in[7]; W0 = (const float*)a.in[8]; K = DM; N = WIN_COLS; P = 256; pk = PK_VT; dst = WS_WVT; break;
                case 6: W0 = (const float*)a.in[10]; K = 2048; N = 256; P = 256; dst = WS_CK1; break;
                case 7: W0 = (const float*)a.in[14]; K = 2048; N = 256; P = 256; dst = WS_CV1; break;
                case 8: W0 = (const float*)a.in[12]; K = 256; N = 64; P = 256; pk = PK_PAD64; dst = WS_CK2; break;
                case 9: W0 = (const float*)a.in[16]; K = 256; N = 64; P = 256; pk = PK_PAD64; dst = WS_CV2; break;
                case 10: W0 = (const float*)a.in[19]; K = 512; N = DM; P = DM; dst = WS_PA; break;
                case 11: W0 = (const float*)a.in[20]; K = 512; N = DM; P = DM; dst = WS_PB; break;
                case 12: W0 = (const float*)a.in[21]; K = DM; N = DM; P = DM; dst = WS_WO; break;
                case 13: gn = (const float*)a.in[26]; W0 = (const float*)a.in[27]; K = DM; N = DM; P = DM; dst = WS_PG; break;
                case 14: W0 = (const float*)a.in[28]; K = 256; N = DM; P = DM; dst = WS_PP; break;
                }
                const int nblk = P / 64, nitems = (K / 64) * nblk;
                int first = (gw - base) % NGW; if (first < 0) first += NGW;
                if (!(PRO_SKIP_T && it_ < 0)) for (int it = first; it < nitems; it += NGW) transpose_item(W0, W1, gn, K, N, pk, (bf16_t*)(ws + dst), scr, it, nblk, lane);
                base += nitems;
            }
            for (int ib = bid * 512; ib < 3 * T; ib += G * 512) ((float*)(ws + WS_SUMSQ))[ib + tid] = 0.f;
            for (int ibs = bid * 512; ibs < T * 32; ibs += 4 * G * 512) { const int ib = ibs + tid;
                int pr[4];
#pragma unroll
                for (int k = 0; k < 4; ++k) { const int idx = ib + k * G * 512; pr[k] = idx < T * 32 ? positions[idx >> 5] : 0; }
#pragma unroll
                for (int k = 0; k < 4; ++k) { const int idx = ib + k * G * 512;
                    if (idx < T * 32) {
                        const double ang = (double)pr[k] * a.invf[idx & 31];
                        const double kk = rint(ang * 0.15915494309189535);
                        double r = fma(-kk, 6.283185307179586, ang); r = fma(-kk, 2.4492935982947064e-16, r);
                        const float rf = (float)r;
                        float2 cs; cs.x = cosf(rf); cs.y = sinf(rf);
                        ((float2*)(ws + WS_ROPE))[idx] = cs; }
                    asm volatile("" ::: "memory"); }
            }
            for (int ob = bid; ob < 256; ob += G) {
                const int mat = ob >> 7, n0 = (ob & 127) * 2;
                const float* posk = (const float*)a.in[9]; const float* posv = (const float*)a.in[13]; const float* w1k = (const float*)a.in[10]; const float* w1v = (const float*)a.in[14]; const float* b1k = (const float*)a.in[11]; const float* b1v = (const float*)a.in[15];
                const float* pos = mat ? posv : posk; const float* w1 = mat ? w1v : w1k; const float* b1 = mat ? b1v : b1k;
                float s0 = 0.f, s1 = 0.f;
#pragma unroll
                for (int i = 0; i < 4; ++i) { const int kk = tid * 4 + i; const float pv = pos[kk]; const float2 wv = *(const float2*)(w1 + (size_t)kk * 256 + n0); s0 += pv * wv.x; s1 += pv * wv.y; }
                s0 = wave_sum(s0); s1 = wave_sum(s1);
                LAS float* red = (LAS float*)(lds + 137216);
                __syncthreads();
                if (lane == 0) { red[wave * 2] = s0; red[wave * 2 + 1] = s1; }
                __syncthreads();
                if (tid < 2) { float tsum = b1[n0 + tid]; for (int q = 0; q < 8; ++q) tsum += red[q * 2 + tid]; ((float*)(ws + (mat ? WS_BIASV : WS_BIASK)))[n0 + tid] = tsum; }
            }
            for (int row = gw; row < T; row += 4 * NGW) norm_rows_n<false, 4>(x, (const float*)a.in[3], U, row, NGW, lane);
        } else if ((ph == PH_PCONV || ph == PH_CONV) && G == 256 && (bid < 16 || bid >= 240)) {
        } else if (ph == PH_PCONV) {
            bf16_t* pb = (bf16_t*)(ws + WS_PBF);
            const int eb = (G == 256) ? bid - 16 : bid, EG = (G == 256) ? 224 : G;
            for (size_t i8 = (size_t)eb * 512 + tid; i8 < (size_t)T * 256 / 8; i8 += (size_t)EG * 512) { const f32x4 v0 = ((const f32x4*)pin)[2 * i8], v1 = ((const f32x4*)pin)[2 * i8 + 1]; ((u32x4*)pb)[i8] = pack8(v0, v1); }
        } else if (ph == PH_FNORM) {
            for (int row = gw; row < T; row += 4 * NGW) norm_rows_n<true, 4>(H, (const float*)a.in[29], a.out, row, NGW, lane);
        } else if (ph == PH_CONV) {
            const bf16_t* cb = (const bf16_t*)(ws + WS_CB); const bf16_t* cc = cb + (size_t)T * 512; const bf16_t* cx = cc + (size_t)T * 512; bf16_t* oc = (bf16_t*)(ws + WS_OCONV);
            const float* cw = (const float*)a.in[17]; const float* cbias = (const float*)a.in[18];
            const int eb = (G == 256) ? bid - 16 : bid, EG = (G == 256) ? 224 : G;
            for (int it = eb * 512 + tid; it < (T / 16) * 64; it += EG * 512) {
                const int c0 = (it & 63) * 8, tc0 = (it >> 6) * 16;
                f32x4 w0a = *(const f32x4*)(cw + c0), w0b = *(const f32x4*)(cw + c0 + 4), w1a = *(const f32x4*)(cw + 512 + c0), w1b = *(const f32x4*)(cw + 512 + c0 + 4);
                f32x4 w2a = *(const f32x4*)(cw + 1024 + c0), w2b = *(const f32x4*)(cw + 1024 + c0 + 4), bia = *(const f32x4*)(cbias + c0), bib = *(const f32x4*)(cbias + c0 + 4);
                f32x4 u2a = {0.f, 0.f, 0.f, 0.f}, u2b = u2a, u1a = u2a, u1b = u2a;
                if ((tc0 & (SEQ - 1)) != 0) {
                    f32x4 ca, cbb, xa, xb;
                    unpack8(*(const u32x4*)(cc + (size_t)(tc0 - 2) * 512 + c0), ca, cbb); unpack8(*(const u32x4*)(cx + (size_t)(tc0 - 2) * 512 + c0), xa, xb); u2a = ca * xa; u2b = cbb * xb;
                    unpack8(*(const u32x4*)(cc + (size_t)(tc0 - 1) * 512 + c0), ca, cbb); unpack8(*(const u32x4*)(cx + (size_t)(tc0 - 1) * 512 + c0), xa, xb); u1a = ca * xa; u1b = cbb * xb;
                }
                u32x4 ncc = *(const u32x4*)(cc + (size_t)tc0 * 512 + c0), ncx = *(const u32x4*)(cx + (size_t)tc0 * 512 + c0), ncb = *(const u32x4*)(cb + (size_t)tc0 * 512 + c0);
#pragma unroll 4
                for (int tt = 0; tt < 16; ++tt) {
                    const size_t o = (size_t)(tc0 + tt) * 512 + c0;
                    const u32x4 wcc = ncc, wcx = ncx, wcb = ncb;
                    if (tt < 15) { ncc = *(const u32x4*)(cc + o + 512); ncx = *(const u32x4*)(cx + o + 512); ncb = *(const u32x4*)(cb + o + 512); }
                    f32x4 ca, cbb, xa, xb, ba, bb;
                    unpack8(wcc, ca, cbb); unpack8(wcx, xa, xb); unpack8(wcb, ba, bb);
                    const f32x4 u0a = ca * xa, u0b = cbb * xb;
                    const f32x4 ya = w0a * u2a + w1a * u1a + w2a * u0a + bia, yb = w0b * u2b + w1b * u1b + w2b * u0b + bib;
                    *(u32x4*)(oc + o) = pack8(ba * ya, bb * yb);
                    u2a = u1a; u2b = u1b; u1a = u0a; u1b = u0b;
                }
            }
        } else if (ph == PH_ATTN) {
            AttnP P; P.q = (const bf16_t*)(ws + WS_Q); P.kcomp = (const bf16_t*)(ws + WS_KCOMP); P.vcompT = (const bf16_t*)(ws + WS_VCOMPT); P.ks = (const bf16_t*)(ws + WS_KS); P.kw = (const bf16_t*)(ws + WS_KW);
            P.VT = (const bf16_t*)(ws + WS_VT); P.gates = (const float*)(ws + WS_GATES); P.scratch = (float*)(ws + WS_CB); P.scratch2 = nullptr; P.onsa = (bf16_t*)(ws + WS_ONSA);
#ifdef ZERO_ATTN
            for (size_t i8 = (size_t)bid * 512 + tid; i8 < (size_t)T * 512 / 8; i8 += (size_t)G * 512) ((u32x4*)P.onsa)[i8] = (u32x4){0u, 0u, 0u, 0u};
#endif
#if !defined(NO_ATTN) && !defined(ZERO_ATTN)
            {
                unsigned* qctr = (unsigned*)ws + 6144; const int bgi = bid & 7;
                LAS unsigned* nxt = (LAS unsigned*)(lds + 140000);
                for (;;) {
                    if (tid == 0) nxt[0] = atomicAdd(qctr + 64 * bgi, 1u);
                    __syncthreads();
                    const unsigned un = nxt[0];
                    __syncthreads();
                    if (un >= 64u) break;
                    attn_unit(lds, P, bgi >> 1, bgi & 1, 63 - (int)un, tid, wave, lane);
                }
            }
#endif

        }
#if !SPLIT_LAUNCH
        if (ph + 1 < a.ph_hi && sync_after(ph)) { if (a.ph_lo < 0) cg::this_grid().sync();   xcd_barrier(xbar); }
#endif
#ifdef SYNC_PROBE
        if (ph == PH_PRO) for (int i_ = 0; i_ < SYNC_PROBE; ++i_) cg::this_grid().sync();
#endif
    }
}

extern "C" void kernel_launch(void* const* d_in, const int* in_sizes, int n_in, void* d_out, int out_size, void* d_ws, size_t ws_size, hipStream_t stream) {
    static int grid = 0;
    if (grid == 0) {
        if (n_in != 30 || out_size != T * DM || ws_size < WS_END) { fprintf(stderr, "kernel_launch: unexpected problem (n_in %d out %d ws %zu)\n", n_in, out_size, ws_size); grid = -1; return; }
        {
            const long long exp_sz[30] = {(long long)T * DM, (long long)T * 256, T, DM, (long long)DM * FF, (long long)DM * FF, (long long)FF * DM, DM, (long long)DM * WIN_COLS, 2048, 2048 * 256, 256, 256 * 64,
                                          2048, 2048 * 256, 256, 256 * 64, 3 * 512, 512, 512 * DM, 512 * DM, (long long)DM * DM, DM, (long long)DM * FF, (long long)DM * FF, (long long)FF * DM, DM, (long long)DM * DM, 256 * DM, DM};
            for (int i = 0; i < 30; ++i) if ((long long)in_sizes[i] != exp_sz[i]) { fprintf(stderr, "kernel_launch: input %d has %d elements, expected %lld\n", i, in_sizes[i], exp_sz[i]); grid = -1; return; }
        }
        int dev = 0, cus = 0, per_cu = 0;
        hipGetDevice(&dev); hipDeviceGetAttribute(&cus, hipDeviceAttributeMultiprocessorCount, dev);
        if (hipFuncSetAttribute((const void*)fwd_kernel, hipFuncAttributeMaxDynamicSharedMemorySize, LDS_BYTES) != hipSuccess) { fprintf(stderr, "kernel_launch: hipFuncSetAttribute failed\n"); grid = -1; return; }
        if (hipOccupancyMaxActiveBlocksPerMultiprocessor(&per_cu, (const void*)fwd_kernel, 512, LDS_BYTES) != hipSuccess || per_cu < 1) { fprintf(stderr, "kernel_launch: occupancy query says %d\n", per_cu); per_cu = 1; }
        (void)hipGetLastError();
        grid = cus * per_cu;
    }
    if (grid < 0) return;
    Args a{};
    for (int i = 0; i < 30; ++i) a.in[i] = d_in[i];
    a.out = (float*)d_out; a.ws = (unsigned char*)d_ws;
    for (int f = 0; f < 32; ++f) a.invf[f] = pow(10000.0, -(double)f / 32.0);
#if SPLIT_LAUNCH
    int lo = 0;
    for (int k = 0; k < PH_N; ++k) if (sync_after(k) || k == PH_N - 1) { a.ph_lo = lo; a.ph_hi = k + 1; hipLaunchKernelGGL(fwd_kernel, dim3(grid), dim3(512), LDS_BYTES, stream, a); lo = k + 1; }
#else
    (void)hipMemsetAsync(d_ws, 0, 32768, stream);
    a.ph_lo = 0; a.ph_hi = PH_N;
    void* args[] = {&a};
    hipError_t e = hipLaunchCooperativeKernel((const void*)fwd_kernel, dim3(grid), dim3(512), args, LDS_BYTES, stream);
    if (e != hipSuccess) fprintf(stderr, "cooperative launch failed: %s (grid %d)\n", hipGetErrorString(e), grid);
#endif
}
```
